# Optimizing an MI355X kernel written in HIP

```python
import jax
import jax.numpy as jnp
from jax import lax
import numpy as np

D_MODEL = 2048
BATCH = 4
SEQ = 4096
DEPTH = 1

EPS = 1e-6
GDN_HEADS = 8
GDN_DK = 128
GDN_DV = 128
CONV_WIDTH = 4
GDN_CHUNK = 64
RET_HEADS = 4
RET_DK = 256
RET_DV = 256
RET_CHUNK = 64
ROPE_BASE = 10000.0
N_EXPERTS = 32
TOP_K = 4
D_EXPERT = D_MODEL
SWIGLU_LIMIT = 7.0
SWIGLU_ALPHA = 1.702
MOE_BLOCK = 256

GDN_QK_W = GDN_HEADS * GDN_DK
GDN_V_W = GDN_HEADS * GDN_DV
RET_QK_W = RET_HEADS * RET_DK
RET_V_W = RET_HEADS * RET_DV
MIX_WIDTH = GDN_V_W + RET_V_W
GDN_CONV_CH = 2 * GDN_QK_W + GDN_V_W
IN_SIZES = (GDN_CONV_CH, GDN_V_W, GDN_HEADS, GDN_HEADS, RET_QK_W, RET_QK_W, RET_V_W, RET_V_W)
IN_COLS = GDN_CONV_CH + GDN_V_W + 2 * GDN_HEADS + 2 * RET_QK_W + 2 * RET_V_W

kernel_name = "hybrid_gdn_retention_moe_adaln_block"


def rmsnorm(x, g):
    x32 = x.astype(jnp.float32)
    y = x32 * lax.rsqrt(jnp.mean(x32 * x32, axis=-1, keepdims=True) + EPS)
    return (y * g.astype(jnp.float32)).astype(x.dtype)


def l2norm(x):
    return x * lax.rsqrt(jnp.sum(x * x, axis=-1, keepdims=True) + EPS)


def causal_depthwise_conv(u, w):
    return lax.conv_general_dilated(u, w[:, None, :].astype(u.dtype), window_strides=(1,),
                                    padding=[(w.shape[0] - 1, 0)],
                                    dimension_numbers=('NWC', 'WIO', 'NWC'),
                                    feature_group_count=u.shape[-1])


def apply_rotary(x, positions):
    half = x.shape[-1] // 2
    inv_freq = jnp.power(ROPE_BASE, -jnp.linspace(0.0, 1.0, half, dtype=jnp.float32))
    ang = positions.astype(jnp.float32)[..., None] * inv_freq
    cos = jnp.cos(ang)[:, :, None, :]
    sin = jnp.sin(ang)[:, :, None, :]
    x1, x2 = x[..., :half], x[..., half:]
    return jnp.concatenate([x1 * cos - x2 * sin, x2 * cos + x1 * sin], axis=-1)


def to_chunks(t, chunk):
    b, s, h = t.shape[:3]
    t = t.reshape((b, s // chunk, chunk, h) + t.shape[3:])
    perm = (0, 3, 1, 2) + tuple(range(4, t.ndim))
    return t.transpose(perm)


def from_chunks(t):
    n, b, h, c, d = t.shape
    return t.transpose(1, 0, 3, 2, 4).reshape(b, n * c, h, d)


def gated_delta_rule(q, k, v, beta, g_step):
    C = GDN_CHUNK
    dv = v.shape[-1]
    q, k, v = (to_chunks(t, C) for t in (q, k, v))
    beta = to_chunks(beta, C)
    g = jnp.cumsum(to_chunks(g_step, C), axis=-1)
    incl = jnp.tril(jnp.ones((C, C), dtype=bool))
    strict = jnp.tril(jnp.ones((C, C), dtype=bool), k=-1)
    diff = g[..., :, None] - g[..., None, :]
    decay_incl = jnp.exp(jnp.where(incl, diff, -jnp.inf))
    decay_strict = jnp.where(strict, decay_incl, 0.0)
    lower = beta[..., :, None] * jnp.einsum('bhnck,bhnmk->bhncm', k, k) * decay_strict
    a_mat = lower + jnp.eye(C, dtype=lower.dtype)
    rhs = jnp.concatenate([beta[..., None] * v, (beta * jnp.exp(g))[..., None] * k], axis=-1)
    sol = lax.linalg.triangular_solve(a_mat, rhs, left_side=True, lower=True, unit_diagonal=True)
    u, w = sol[..., :dv], sol[..., dv:]
    a_qk = jnp.einsum('bhnck,bhnmk->bhncm', q, k) * decay_incl
    q_dec = q * jnp.exp(g)[..., None]
    k_end = k * jnp.exp(g[..., -1:] - g)[..., None]
    chunk_decay = jnp.exp(g[..., -1])
    xs = tuple(jnp.moveaxis(t, 2, 0) for t in (q_dec, k_end, u, w, a_qk, chunk_decay))

    def step(state, inp):
        qd, ke, uc, wc, aqk, cd = inp
        delta = uc - jnp.einsum('bhck,bhkv->bhcv', wc, state)
        out = jnp.einsum('bhck,bhkv->bhcv', qd, state) + jnp.einsum('bhcm,bhmv->bhcv', aqk, delta)
        state = cd[..., None, None] * state + jnp.einsum('bhck,bhcv->bhkv', ke, delta)
        return state, out

    b, h, _, _, dk = q.shape
    s0 = jnp.zeros((b, h, dk, dv), jnp.float32)
    _, out = lax.scan(step, s0, xs)
    return from_chunks(out)


def multiscale_retention(q, k, v):
    C = RET_CHUNK
    h = q.shape[2]
    log_gamma = jnp.log1p(-jnp.exp2(-5.0 - jnp.arange(h, dtype=jnp.float32)))
    q, k, v = (to_chunks(t, C) for t in (q, k, v))
    pos = jnp.arange(C, dtype=jnp.float32)
    incl = jnp.tril(jnp.ones((C, C), dtype=bool))
    d_mat = jnp.exp(jnp.where(incl, (pos[:, None] - pos[None, :]) * log_gamma[:, None, None], -jnp.inf))
    scores = jnp.einsum('bhnck,bhnmk->bhncm', q, k) * d_mat[None, :, None]
    inner = jnp.einsum('bhncm,bhnmv->bhncv', scores, v)
    q_dec = q * jnp.exp((pos + 1.0) * log_gamma[:, None])[None, :, None, :, None]
    k_dec = k * jnp.exp((C - 1.0 - pos) * log_gamma[:, None])[None, :, None, :, None]
    chunk_decay = jnp.exp(C * log_gamma)[None, :, None, None]
    xs = tuple(jnp.moveaxis(t, 2, 0) for t in (q_dec, k_dec, v, inner))

    def step(state, inp):
        qd, kd, vc, inn = inp
        out = inn + jnp.einsum('bhck,bhkv->bhcv', qd, state)
        state = chunk_decay * state + jnp.einsum('bhck,bhcv->bhkv', kd, vc)
        return state, out

    b, _, _, _, dk = q.shape
    s0 = jnp.zeros((b, h, dk, v.shape[-1]), jnp.float32)
    _, out = lax.scan(step, s0, xs)
    return from_chunks(out)


def hybrid_mixer(h, positions, w_in, conv_w, a_log, dt_bias, gdn_norm_g, ret_norm_g, ret_norm_b, w_out):
    b, s, _ = h.shape
    f32 = jnp.float32
    proj = h @ w_in
    cuts = np.cumsum(IN_SIZES)[:-1].tolist()
    g_qkv, g_z, g_b, g_a, r_q, r_k, r_v, r_g = jnp.split(proj, cuts, axis=-1)
    g_qkv = jax.nn.silu(causal_depthwise_conv(g_qkv, conv_w)).astype(f32)
    gq, gk, gv = jnp.split(g_qkv, [GDN_QK_W, 2 * GDN_QK_W], axis=-1)
    gq = l2norm(gq.reshape(b, s, GDN_HEADS, GDN_DK)) * (GDN_DK ** -0.5)
    gk = l2norm(gk.reshape(b, s, GDN_HEADS, GDN_DK))
    gv = gv.reshape(b, s, GDN_HEADS, GDN_DV)
    beta = jax.nn.sigmoid(g_b.astype(f32))
    g_step = -jnp.exp(a_log.astype(f32)) * jax.nn.softplus(g_a.astype(f32) + dt_bias.astype(f32))
    o_g = gated_delta_rule(gq, gk, gv, beta, g_step)
    o_g = o_g * lax.rsqrt(jnp.mean(o_g * o_g, axis=-1, keepdims=True) + EPS) * gdn_norm_g.astype(f32)
    o_g = (o_g * jax.nn.silu(g_z.astype(f32).reshape(b, s, GDN_HEADS, GDN_DV))).reshape(b, s, GDN_V_W)
    rq = apply_rotary(r_q.astype(f32).reshape(b, s, RET_HEADS, RET_DK), positions)
    rk = apply_rotary(r_k.astype(f32).reshape(b, s, RET_HEADS, RET_DK), positions) * (RET_DK ** -0.5)
    rv = r_v.astype(f32).reshape(b, s, RET_HEADS, RET_DV)
    o_r = multiscale_retention(rq, rk, rv)
    mu = jnp.mean(o_r, axis=-1, keepdims=True)
    var = jnp.mean(jnp.square(o_r - mu), axis=-1, keepdims=True)
    o_r = ((o_r - mu) * lax.rsqrt(var + EPS)).reshape(b, s, RET_V_W)
    o_r = (o_r * ret_norm_g.astype(f32) + ret_norm_b.astype(f32)) * jax.nn.silu(r_g.astype(f32))
    mixed = jnp.concatenate([o_g, o_r], axis=-1).astype(h.dtype)
    return mixed @ w_out


def moe_ffn(h, w_router, b_router, w1, b1, w2, b2):
    b, s, d = h.shape
    t = b * s
    xf = h.reshape(t, d)
    logits = (xf @ w_router + b_router).astype(jnp.float32)
    top_val, top_idx = lax.top_k(logits, TOP_K)
    gates = jax.nn.softmax(top_val, axis=-1)
    flat_e = top_idx.reshape(-1)
    flat_t = jnp.repeat(jnp.arange(t, dtype=jnp.int32), TOP_K)
    flat_g = gates.reshape(-1)
    order = jnp.argsort(flat_e)
    se, st, sg = flat_e[order], flat_t[order], flat_g[order]
    counts = jnp.bincount(flat_e, length=N_EXPERTS)
    starts = jnp.cumsum(counts) - counts
    padded = (counts + MOE_BLOCK - 1) // MOE_BLOCK * MOE_BLOCK
    pad_ends = jnp.cumsum(padded)
    pad_starts = pad_ends - padded
    dest = pad_starts[se] + jnp.arange(t * TOP_K, dtype=jnp.int32) - starts[se]
    n_blocks = (t * TOP_K) // MOE_BLOCK + N_EXPERTS
    n_rows = n_blocks * MOE_BLOCK
    row_tok = jnp.full((n_rows,), t, jnp.int32).at[dest].set(st)
    row_gate = jnp.zeros((n_rows,), jnp.float32).at[dest].set(sg)
    block_e = jnp.minimum(jnp.searchsorted(pad_ends, jnp.arange(n_blocks) * MOE_BLOCK, side='right'),
                          N_EXPERTS - 1)
    x_pad = jnp.concatenate([xf, jnp.zeros((1, d), xf.dtype)], axis=0)

    def expert_block(args):
        tok, gate, e = args
        hid = x_pad[tok] @ w1[e] + b1[e]
        x_glu, x_lin = jnp.split(hid, 2, axis=-1)
        x_glu = jnp.minimum(x_glu, SWIGLU_LIMIT)
        x_lin = jnp.clip(x_lin, -SWIGLU_LIMIT, SWIGLU_LIMIT)
        act = x_glu * jax.nn.sigmoid(SWIGLU_ALPHA * x_glu) * (x_lin + 1.0)
        return (act @ w2[e] + b2[e]) * gate[:, None].astype(hid.dtype)

    ys = lax.map(expert_block, (row_tok.reshape(n_blocks, MOE_BLOCK),
                                row_gate.reshape(n_blocks, MOE_BLOCK), block_e))
    out = jax.ops.segment_sum(ys.reshape(n_rows, d), row_tok, num_segments=t + 1)[:t]
    return out.reshape(b, s, d)


def setup_inputs(seed: int = 0) -> dict:
    key = jax.random.key(seed)
    ks = jax.random.split(key, 24)
    f32 = jnp.float32
    L, D, E, F = DEPTH, D_MODEL, N_EXPERTS, D_EXPERT

    def nrm(k, shape, scale):
        return scale * jax.random.normal(k, shape, f32)

    x = jax.random.normal(ks[0], (BATCH, SEQ, D), f32)
    c = jax.random.normal(ks[1], (BATCH, D), f32)
    start = jax.random.randint(ks[2], (BATCH, 1), 0, 1024, dtype=jnp.int32)
    positions = start + jnp.arange(SEQ, dtype=jnp.int32)[None, :]
    return {
        'x': x,
        'c': c,
        'positions': positions,
        'ada_w': nrm(ks[3], (L, D, 6 * D), D ** -0.5),
        'ada_b': nrm(ks[4], (L, 6 * D), 0.02),
        'norm1_g': 1.0 + nrm(ks[5], (L, D), 0.02),
        'w_in': nrm(ks[6], (L, D, IN_COLS), D ** -0.5),
        'conv_w': nrm(ks[7], (L, CONV_WIDTH, GDN_CONV_CH), CONV_WIDTH ** -0.5),
        'gdn_a_log': jnp.log(jax.random.uniform(ks[8], (L, GDN_HEADS), f32, 1.0, 16.0)),
        'gdn_dt_bias': nrm(ks[9], (L, GDN_HEADS), 0.5),
        'gdn_norm_g': 1.0 + nrm(ks[10], (L, GDN_DV), 0.02),
        'ret_norm_g': 1.0 + nrm(ks[11], (L, RET_V_W), 0.02),
        'ret_norm_b': nrm(ks[12], (L, RET_V_W), 0.02),
        'w_out': nrm(ks[13], (L, MIX_WIDTH, D), MIX_WIDTH ** -0.5),
        'norm2_g': 1.0 + nrm(ks[14], (L, D), 0.02),
        'w_router': nrm(ks[15], (L, D, E), D ** -0.5),
        'b_router': nrm(ks[16], (L, E), 0.01),
        'w1': nrm(ks[17], (L, E, D, 2 * F), D ** -0.5),
        'b1': nrm(ks[18], (L, E, 2 * F), 0.01),
        'w2': nrm(ks[19], (L, E, F, D), F ** -0.5),
        'b2': nrm(ks[20], (L, E, D), 0.01),
        'final_norm_g': 1.0 + nrm(ks[21], (D,), 0.02),
    }


def reference(x, c, positions, ada_w, ada_b, norm1_g, w_in, conv_w, gdn_a_log, gdn_dt_bias, gdn_norm_g,
              ret_norm_g, ret_norm_b, w_out, norm2_g, w_router, b_router, w1, b1, w2, b2, final_norm_g):
    cond = jax.nn.silu(c)
    for l in range(DEPTH):
        mod = (cond @ ada_w[l] + ada_b[l])[:, None, :]
        sh1, sc1, gt1, sh2, sc2, gt2 = jnp.split(mod, 6, axis=-1)
        h = rmsnorm(x, norm1_g[l]) * (1.0 + sc1) + sh1
        x = x + gt1 * hybrid_mixer(h, positions, w_in[l], conv_w[l], gdn_a_log[l], gdn_dt_bias[l],
                                   gdn_norm_g[l], ret_norm_g[l], ret_norm_b[l], w_out[l])
        h = rmsnorm(x, norm2_g[l]) * (1.0 + sc2) + sh2
        x = x + gt2 * moe_ffn(h, w_router[l], b_router[l], w1[l], b1[l], w2[l], b2[l])
    return rmsnorm(x, final_norm_g)
```

```cpp
#include <hip/hip_runtime.h>
#include <cstdio>
#include <cstdint>

#ifndef N_LAUNCH_MODE
#define N_LAUNCH_MODE 1
#endif
#ifndef NAIVE_GEMM
#define NAIVE_GEMM 0
#endif
#ifndef NAIVE_MIXER
#define NAIVE_MIXER 0
#endif

#define GAS __attribute__((address_space(1)))
#define LAS __attribute__((address_space(3)))
typedef unsigned short bf16;
typedef unsigned v4u __attribute__((ext_vector_type(4)));
typedef unsigned v2u __attribute__((ext_vector_type(2)));
typedef float f32x4 __attribute__((ext_vector_type(4)));
typedef float f32x2 __attribute__((ext_vector_type(2)));
typedef short bf16x8 __attribute__((ext_vector_type(8)));

constexpr int NB = 4, SEQ = 4096, T = NB * SEQ, D = 2048;
constexpr int GH = 8, GDK = 128, RH = 4, RDK = 256;
constexpr int NE = 32, TOPK = 4;
constexpr int INC = 8208, NPROJ = 8192, MODW = 6 * D;
constexpr int MAXROWS = T * TOPK + NE * 256;
constexpr float EPS = 1e-6f;
constexpr int NTHREADS = 512, NWAVES = 8;
constexpr int NPHASES = 12;

constexpr size_t MiB = 1u << 20;
constexpr size_t WS_CTL = 0, CTL_ZERO_BYTES = 2 * MiB;
constexpr size_t WS_MOD = 1 * MiB;
constexpr size_t WS_TOKE = 2 * MiB;
constexpr size_t WS_TOKG = WS_TOKE + 256 * 1024;
constexpr size_t WS_TOKP = WS_TOKG + 256 * 1024;
constexpr size_t WS_BCNT = WS_TOKP + 256 * 1024;
constexpr size_t WS_TILEE = WS_BCNT + 128 * 1024;
constexpr size_t WS_META = WS_TILEE + 4096;
constexpr size_t WS_RGATE = 3 * MiB;
constexpr size_t WS_RTOK = 3 * MiB + 512 * 1024;
constexpr size_t WS_BA = 4 * MiB;
constexpr size_t WS_WBAT = 5 * MiB;
constexpr size_t WS_WRT = 5 * MiB + 256 * 1024;
constexpr size_t WS_WIN = 8 * MiB;
constexpr size_t WS_WOUT = 40 * MiB;
constexpr size_t WS_W1 = 48 * MiB;
constexpr size_t WS_W2 = 560 * MiB;
constexpr size_t WS_H = 816 * MiB;
constexpr size_t WS_PROJ = 880 * MiB;
constexpr size_t WS_O = 1136 * MiB;
constexpr size_t WS_X1 = 1264 * MiB;
constexpr size_t WS_XS = 1392 * MiB;
constexpr size_t WS_ACT = 1680 * MiB;
constexpr size_t WS_Y = 1968 * MiB;
constexpr size_t WS_GIMG = 2256 * MiB;
constexpr size_t WS_GU = 2368 * MiB;
constexpr size_t WS_RIMG = 2432 * MiB;
constexpr size_t WS_RINNER = 2496 * MiB;
constexpr size_t WS_RVF = 2560 * MiB;
constexpr size_t WS_GCD = 2592 * MiB;
constexpr size_t WS_ROT = 2593 * MiB;
constexpr size_t WS_END = 2609 * MiB;
constexpr int GIMG_BYTES = 57344, RIMG_BYTES = 65536;
constexpr int CW_BAR = 4096;
constexpr int CW_CONVQ = 64;

constexpr int LDS_BYTES = 160 * 1024;
constexpr int MISC_OFF = LDS_BYTES - 256;

#define LDS_WAIT() asm volatile("s_waitcnt lgkmcnt(0)" ::: "memory")
#define VM_WAIT() asm volatile("s_waitcnt vmcnt(0)" ::: "memory")
typedef __bf16 bf16v2_t __attribute__((ext_vector_type(2)));
__device__ __forceinline__ unsigned cvt2(float lo, float hi) { const f32x2 v = {lo, hi}; return __builtin_bit_cast(unsigned, __builtin_convertvector(v, bf16v2_t)); }
__device__ __forceinline__ unsigned pk2(float lo, float hi) { return cvt2(lo, hi); }
__device__ __forceinline__ unsigned f2bf(float f) { return (unsigned)__builtin_bit_cast(unsigned short, (__bf16)f); }
__device__ __forceinline__ float bf2f(unsigned b) { return __uint_as_float(b << 16); }
__device__ __forceinline__ float bflo(unsigned w) { return __uint_as_float(w << 16); }
__device__ __forceinline__ float bfhi(unsigned w) { return __uint_as_float(w & 0xffff0000u); }
__device__ __forceinline__ float wave_sum(float v) {
#pragma unroll
    for (int o = 1; o < 64; o <<= 1) v += __shfl_xor(v, o);
    return v;
}
__device__ __forceinline__ void lds_inc(LAS int* p) { (void)__hip_atomic_fetch_add(p, 1, __ATOMIC_RELAXED, __HIP_MEMORY_SCOPE_WORKGROUP); }
__device__ __forceinline__ float siluf(float v) { return v / (1.f + __expf(-v)); }
__device__ __forceinline__ float sigmoidf_(float v) { return 1.f / (1.f + __expf(-v)); }
__device__ __forceinline__ float softplusf_(float v) { return v > 20.f ? v : log1pf(expf(v)); }

#define XB_TMO      128
#define XB_XCNT(j)  (256  + 64 * (j))
#define XB_XSUB(j)  (1280 + 64 * (j))
#define XB_XGEN(j)  (2304 + 64 * (j))
#define XB_TOP      3328
#define XB_TOPGEN   3392
#define XCD_BAR_WORDS 3456
#define XB_SPIN_CAP (1u << 24)
__device__ __forceinline__ unsigned xb_ld(unsigned* p)              { return __hip_atomic_load(p, __ATOMIC_RELAXED, __HIP_MEMORY_SCOPE_AGENT); }
__device__ __forceinline__ unsigned xb_add(unsigned* p, unsigned v) { return __hip_atomic_fetch_add(p, v, __ATOMIC_RELAXED, __HIP_MEMORY_SCOPE_AGENT); }
__device__ __forceinline__ unsigned xb_xcc_id() { return (unsigned)__builtin_amdgcn_s_getreg((3 << 11) | 20) & 0xFu; }
#define XB_SPIN(cond, bar) do { unsigned _sp = 0; while (cond) { __builtin_amdgcn_s_sleep(1); \
    if ((++_sp & 255u) == 0u) { if (xb_ld(&(bar)[XB_TMO])) break; if (_sp > XB_SPIN_CAP) { atomicAdd(&(bar)[XB_TMO], 1u); break; } } } } while (0)
struct XcdBarrier { unsigned* bar; unsigned x; volatile LAS unsigned* st; };
__device__ __forceinline__ XcdBarrier xcd_barrier_post(unsigned* bar, volatile LAS unsigned* st) {
    XcdBarrier b; b.bar = bar; b.x = xb_xcc_id(); b.st = st;
    if (threadIdx.x == 0) (void)xb_add(&bar[XB_XCNT(b.x)], 1u);
    return b;
}
__device__ __forceinline__ void xcd_barrier_complete(unsigned* bar, unsigned x, unsigned& nloc, unsigned& nx) {
    const unsigned G = gridDim.x * gridDim.y * gridDim.z;
    unsigned sum, cnt, mine, sp = 0u;
    for (;;) {
        sum = 0u; cnt = 0u; mine = 0u;
#pragma unroll
        for (unsigned j = 0; j < 16; ++j) { const unsigned c = xb_ld(&bar[XB_XCNT(j)]); sum += c; cnt += (c > 0u) ? 1u : 0u; mine = (j == x) ? c : mine; }
        if (sum == G) break;
        __builtin_amdgcn_s_sleep(1);
        if ((++sp & 255u) == 0u) { if (xb_ld(&bar[XB_TMO])) break; if (sp > XB_SPIN_CAP) { atomicAdd(&bar[XB_TMO], 1u); break; } }
    }
    nloc = mine > 0u ? mine : 1u; nx = cnt > 0u ? cnt : 1u;
}
__device__ __forceinline__ void xcd_barrier(const XcdBarrier& b) {
    asm volatile("s_waitcnt vmcnt(0)" ::: "memory");
    __syncthreads();
    if (threadIdx.x == 0) {
        unsigned* bar = b.bar;
        __builtin_amdgcn_s_waitcnt(0);
        unsigned nloc = b.st[0], nx = b.st[1];
        if (nloc == 0u) { xcd_barrier_complete(bar, b.x, nloc, nx); b.st[0] = nloc; b.st[1] = nx; }
        const unsigned old = xb_add(&bar[XB_XSUB(b.x)], 1u);
        const unsigned gen = old / nloc;
        if (old + 1u == (gen + 1u) * nloc) {
            __builtin_amdgcn_fence(__ATOMIC_RELEASE, "agent");
            asm volatile("s_waitcnt vmcnt(0)" ::: "memory");
            const unsigned og = xb_add(&bar[XB_TOP], 1u);
            const unsigned tg = og / nx;
            if (og + 1u == (tg + 1u) * nx) xb_add(&bar[XB_TOPGEN], 1u);
            else XB_SPIN(xb_ld(&bar[XB_TOPGEN]) == tg, bar);
            __builtin_amdgcn_fence(__ATOMIC_ACQUIRE, "agent");
            xb_add(&bar[XB_XGEN(b.x)], 1u);
            asm volatile("s_waitcnt vmcnt(0)" ::: "memory");
        } else {
            XB_SPIN(xb_ld(&bar[XB_XGEN(b.x)]) == gen, bar);
            __builtin_amdgcn_fence(__ATOMIC_ACQUIRE, "agent");
            asm volatile("s_waitcnt vmcnt(0)" ::: "memory");
        }
    }
    __syncthreads();
}

struct Ctx {
    LAS unsigned char* lds;
    int tid, lane, wave, G, bid;
    const float *x, *c_in; const int* positions;
    const float *ada_w, *ada_b, *norm1_g, *w_in, *conv_w, *a_log, *dt_bias, *gdn_norm_g, *ret_norm_g, *ret_norm_b, *w_out, *norm2_g, *w_router, *b_router, *w1, *b1, *w2, *b2, *final_g;
    float* out;
    unsigned* ctl; float* mod; int* tok_e; float* tok_g; int* tok_pos; int* blk_cnt; int* tile_e; int* meta; float* row_gate; int* row_tok;
    float* ba; float* wba_t; float* wr_t;
    bf16 *win_t, *wout_t, *H, *PROJ, *Y;
    unsigned char *w1_q, *w2_q, *H8, *XS8, *ACT8;
    float *O; bf16* X1; bf16* Ob;
    unsigned char *gimg, *rimg, *rvf; float *gu, *rinner, *gcd; f32x2* rot;
};

__device__ __forceinline__ void ph_mod(const Ctx& c) {
    LAS float* cond = (LAS float*)(c.lds);
    LAS float* red = (LAS float*)(c.lds + 32768);
    bool did = false;
    for (int u = c.bid; u < MODW / 64; u += c.G) {
        if (!did) { for (int i = c.tid; i < NB * D; i += NTHREADS) { const float v = c.c_in[i]; cond[i] = v / (1.f + expf(-v)); } __syncthreads(); did = true; }
        const int col = u * 64 + c.lane, kbase = c.wave * 256;
        float acc[4] = {0.f, 0.f, 0.f, 0.f};
        const float* wp = c.ada_w + (size_t)kbase * MODW + col;
#pragma unroll 16
        for (int k = 0; k < 256; ++k) {
            const float w = wp[(size_t)k * MODW];
#pragma unroll
            for (int b = 0; b < 4; ++b) acc[b] += cond[b * D + kbase + k] * w;
        }
#pragma unroll
        for (int b = 0; b < 4; ++b) red[(c.wave * 4 + b) * 64 + c.lane] = acc[b];
        __syncthreads();
        if (c.tid < 256) { const int b = c.tid >> 6, cc = c.tid & 63; float s = c.ada_b[u * 64 + cc];
#pragma unroll
            for (int w = 0; w < 8; ++w) s += red[(w * 4 + b) * 64 + cc];
            c.mod[b * MODW + u * 64 + cc] = s; }
        __syncthreads();
    }
}
__device__ __forceinline__ void transpose_item(const float* W, int ldw, int scol0, int k0, bf16* WT, size_t drow0, int ldk, LAS float* scr, int lane) {
#pragma unroll 8
    for (int i = 0; i < 32; ++i) { const int kk = 2 * i + (lane >> 5); scr[kk * 33 + (lane & 31)] = W[(size_t)(k0 + kk) * ldw + scol0 + (lane & 31)]; }
    LDS_WAIT(); asm volatile("" ::: "memory");
    const int cch = lane & 7;
#pragma unroll
    for (int j = 0; j < 4; ++j) { const int n = (lane >> 3) + 8 * j; const LAS float* s = scr + (8 * cch) * 33 + n;
        v4u o; o.x = pk2(s[0 * 33], s[1 * 33]); o.y = pk2(s[2 * 33], s[3 * 33]); o.z = pk2(s[4 * 33], s[5 * 33]); o.w = pk2(s[6 * 33], s[7 * 33]);
        *(GAS v4u*)(WT + (drow0 + n) * ldk + k0 + 8 * cch) = o; }
    LDS_WAIT(); asm volatile("" ::: "memory");
}
__device__ __forceinline__ unsigned pk4_fp8(float a, float b, float c2, float d) {
    a = fminf(fmaxf(a, -448.f), 448.f); b = fminf(fmaxf(b, -448.f), 448.f); c2 = fminf(fmaxf(c2, -448.f), 448.f); d = fminf(fmaxf(d, -448.f), 448.f);
    int w = 0; w = __builtin_amdgcn_cvt_pk_fp8_f32(a, b, w, false); w = __builtin_amdgcn_cvt_pk_fp8_f32(c2, d, w, true); return (unsigned)w;
}
__device__ __forceinline__ unsigned pk4_fp8_nc(float a, float b, float c2, float d) {
    int w = 0; w = __builtin_amdgcn_cvt_pk_fp8_f32(a, b, w, false); w = __builtin_amdgcn_cvt_pk_fp8_f32(c2, d, w, true); return (unsigned)w;
}
constexpr float W8_SCALE = 256.f;
__device__ __forceinline__ void transpose_item_f8(const float* W, int ldw, int scol0, int k0, unsigned char* WT, size_t drow0, int ldk, LAS float* scr, int lane) {
#pragma unroll 8
    for (int i = 0; i < 32; ++i) { const int kk = 2 * i + (lane >> 5); scr[kk * 33 + (lane & 31)] = W[(size_t)(k0 + kk) * ldw + scol0 + (lane & 31)]; }
    LDS_WAIT(); asm volatile("" ::: "memory");
    const int cch = lane & 7;
#pragma unroll
    for (int j = 0; j < 4; ++j) { const int n = (lane >> 3) + 8 * j; const LAS float* s = scr + (8 * cch) * 33 + n;
        v2u o; o.x = pk4_fp8(s[0 * 33] * W8_SCALE, s[1 * 33] * W8_SCALE, s[2 * 33] * W8_SCALE, s[3 * 33] * W8_SCALE); o.y = pk4_fp8(s[4 * 33] * W8_SCALE, s[5 * 33] * W8_SCALE, s[6 * 33] * W8_SCALE, s[7 * 33] * W8_SCALE);
        *(GAS v2u*)(WT + (drow0 + n) * ldk + k0 + 8 * cch) = o; }
    LDS_WAIT(); asm volatile("" ::: "memory");
}
__device__ __forceinline__ void f8item_addr(const Ctx& c, int r, const float*& W, int& ldw, int& scol, int& k0, unsigned char*& WT, size_t& drow0) {
    if (r < 32 * 32 * 128) { const int e = r >> 12, kb = (r >> 7) & 31, nb = r & 127, n0 = 32 * nb; scol = ((n0 >> 7) & 1) * 2048 + (n0 >> 8) * 128 + (n0 & 127);
        W = c.w1 + (size_t)e * D * 4096; ldw = 4096; k0 = 64 * kb; WT = c.w1_q; drow0 = (size_t)e * 4096 + n0; }
    else { r -= 32 * 32 * 128; const int e = r >> 11, kb = (r >> 6) & 31, nb = r & 63; scol = 32 * nb; W = c.w2 + (size_t)e * D * D; ldw = D; k0 = 64 * kb; WT = c.w2_q; drow0 = (size_t)e * D + 32 * nb; }
}
__device__ __forceinline__ void f8item_load(const float* W, int ldw, int scol, int k0, int lane, f32x4 (&rg)[8]) {
    const float* p = W + (size_t)(k0 + (lane >> 3)) * ldw + scol + 4 * (lane & 7);
#pragma unroll
    for (int i = 0; i < 8; ++i) rg[i] = *(const f32x4*)(p + (size_t)(8 * i) * ldw);
}
__device__ __forceinline__ void f8item_emit(const f32x4 (&rg)[8], unsigned char* WT, size_t drow0, int k0, LAS float* scr, int lane) {
#pragma unroll
    for (int i = 0; i < 8; ++i) { LAS float* d = scr + (8 * i + (lane >> 3)) * 33 + 4 * (lane & 7); d[0] = rg[i].x; d[1] = rg[i].y; d[2] = rg[i].z; d[3] = rg[i].w; }
    LDS_WAIT(); asm volatile("" ::: "memory");
    const int cch = lane & 7;
#pragma unroll
    for (int j = 0; j < 4; ++j) { const int n = (lane >> 3) + 8 * j; const LAS float* s = scr + (8 * cch) * 33 + n;
        v2u o; o.x = pk4_fp8(s[0 * 33] * W8_SCALE, s[1 * 33] * W8_SCALE, s[2 * 33] * W8_SCALE, s[3 * 33] * W8_SCALE); o.y = pk4_fp8(s[4 * 33] * W8_SCALE, s[5 * 33] * W8_SCALE, s[6 * 33] * W8_SCALE, s[7 * 33] * W8_SCALE);
        *(GAS v2u*)(WT + (drow0 + n) * D + k0 + 8 * cch) = o; }
    LDS_WAIT(); asm volatile("" ::: "memory");
}
constexpr int IT_WIN = 32 * 256, IT_WOUT = 32 * 64, IT_W1 = 32 * 32 * 128, IT_W2 = 32 * 32 * 64;
constexpr int IT_SMALL = IT_WIN + IT_WOUT, IT_ALL = IT_SMALL + IT_W1 + IT_W2;
constexpr int SCAN_UNITS = 64;
__device__ __forceinline__ void convert_items(const Ctx& c, int it0, int it1, int wk, int nwk, LAS unsigned char* scrbase) {
    LAS float* scr = (LAS float*)(scrbase + c.wave * 8704);
    for (int it = it0 + wk; it < it1; it += nwk) {
        int r = it;
        if (r < IT_WIN) { const int kb = r >> 8, nb = r & 255, n0 = 32 * nb; transpose_item(c.w_in, INC, n0 < 4096 ? n0 : n0 + 16, 64 * kb, c.win_t, n0, D, scr, c.lane); continue; }
        r -= IT_WIN;
        if (r < IT_WOUT) { const int kb = r >> 6, nb = r & 63; transpose_item(c.w_out, D, 32 * nb, 64 * kb, c.wout_t, 32 * nb, D, scr, c.lane); continue; }
        r -= IT_WOUT;
        if (r < IT_W1) { const int e = r >> 12, kb = (r >> 7) & 31, nb = r & 127, n0 = 32 * nb; const int scol = ((n0 >> 7) & 1) * 2048 + (n0 >> 8) * 128 + (n0 & 127);
            transpose_item_f8(c.w1 + (size_t)e * D * 4096, 4096, scol, 64 * kb, c.w1_q, (size_t)e * 4096 + n0, D, scr, c.lane); continue; }
        r -= IT_W1;
        { const int e = r >> 11, kb = (r >> 6) & 31, nb = r & 63; transpose_item_f8(c.w2 + (size_t)e * D * D, D, 32 * nb, 64 * kb, c.w2_q, (size_t)e * D + 32 * nb, D, scr, c.lane); }
    }
}
__device__ __forceinline__ void ph_prologue(const Ctx& c) {
    ph_mod(c);
    __syncthreads();
    for (int i = c.bid * NTHREADS + c.tid; i < 16 * D; i += c.G * NTHREADS) { const int k = i >> 4, j = i & 15; c.wba_t[j * D + k] = c.w_in[(size_t)k * INC + 4096 + j]; }
    for (int i = c.bid * NTHREADS + c.tid; i < 32 * D; i += c.G * NTHREADS) { const int k = i >> 5, e = i & 31; c.wr_t[e * D + k] = c.w_router[k * 32 + e]; }
    for (int i = c.bid * NTHREADS + c.tid; i < T * 128; i += c.G * NTHREADS) { const int t = i >> 7, j = i & 127;
        const float invf = exp2f(-(float)j * (13.287712379549449f / 127.f)); float sn, cs; sincosf((float)c.positions[t] * invf, &sn, &cs); c.rot[i] = (f32x2){cs, sn}; }
    convert_items(c, 0, c.G > SCAN_UNITS ? IT_SMALL : IT_ALL, c.bid * NWAVES + c.wave, c.G * NWAVES, c.lds);
}

__device__ __forceinline__ int tokens_per_block(int G);
__device__ __forceinline__ void ph_norm1(const Ctx& c) {
    constexpr int RSB = 2056;
    LAS bf16* hH = (LAS bf16*)c.lds;
    LAS bf16* hL = hH + 16 * RSB;
    LAS float* part = (LAS float*)(c.lds + 2 * 16 * RSB * 2);
    LAS float* GpL = part + 2048;
    LAS float* ShL = GpL + 2048;
    const int TPB = tokens_per_block(c.G), base = c.bid * TPB;
    const int lane = c.lane, w = c.wave, fi = lane & 15, kq = lane >> 4;
    if (base >= T) return;
    f32x4 xn[2][8];
    { const int m0 = base + 2 * w; const int mr = m0 < T ? m0 : 0;
#pragma unroll
      for (int r = 0; r < 2; ++r) { const float* xr = c.x + (size_t)(mr + r) * D + 8 * lane;
#pragma unroll
          for (int j = 0; j < 4; ++j) { xn[r][2 * j] = *(const f32x4*)(xr + 512 * j); xn[r][2 * j + 1] = *(const f32x4*)(xr + 512 * j + 4); } } }
    bf16x8 wbH[8], wbL[8];
    { const float* bp = c.wba_t + (size_t)fi * D + 256 * w + 8 * kq;
#pragma unroll
      for (int s2 = 0; s2 < 8; ++s2) { const f32x4 f0 = *(const f32x4*)(bp + 32 * s2), f1 = *(const f32x4*)(bp + 32 * s2 + 4);
          const unsigned h0 = cvt2(f0.x, f0.y), h1 = cvt2(f0.z, f0.w), h2 = cvt2(f1.x, f1.y), h3 = cvt2(f1.z, f1.w);
          const unsigned l0 = cvt2(f0.x - bflo(h0), f0.y - bfhi(h0)), l1 = cvt2(f0.z - bflo(h1), f0.w - bfhi(h1)), l2 = cvt2(f1.x - bflo(h2), f1.y - bfhi(h2)), l3 = cvt2(f1.z - bflo(h3), f1.w - bfhi(h3));
          wbH[s2] = __builtin_bit_cast(bf16x8, (v4u){h0, h1, h2, h3}); wbL[s2] = __builtin_bit_cast(bf16x8, (v4u){l0, l1, l2, l3}); } }
    int cbat = -1;
    for (int p0 = 0; p0 < TPB; p0 += 16) {
        if (base + p0 >= T) break;
        const int bat = (base + p0) >> 12;
        if (bat != cbat) {
            cbat = bat; __syncthreads();
            const float* mb = c.mod + bat * MODW; const int col = 4 * c.tid;
            const f32x4 g = *(const f32x4*)(c.norm1_g + col), sc = *(const f32x4*)(mb + D + col), sh = *(const f32x4*)(mb + col);
            *(LAS f32x4*)(GpL + col) = g * (1.f + sc); *(LAS f32x4*)(ShL + col) = sh;
            __syncthreads();
        }
        {
            const int m0 = base + p0 + 2 * w;
            const bool ok = m0 < T;
            const int mr = ok ? m0 : 0;
#pragma unroll
            for (int r = 0; r < 2; ++r) {
                float ss = 0.f;
#pragma unroll
                for (int j = 0; j < 8; ++j) ss += (xn[r][j].x * xn[r][j].x + xn[r][j].y * xn[r][j].y) + (xn[r][j].z * xn[r][j].z + xn[r][j].w * xn[r][j].w);
                const float rstd = rsqrtf(wave_sum(ss) * (1.f / D) + EPS);
                v4u* o8 = (v4u*)(c.H + (size_t)(mr + r) * D) + lane; const int lo = (2 * w + r) * RSB + 8 * lane;
#pragma unroll
                for (int j = 0; j < 4; ++j) { const int col = 8 * lane + 512 * j;
                    const f32x4 gp0 = *(const LAS f32x4*)(GpL + col), gp1 = *(const LAS f32x4*)(GpL + col + 4), sh0 = *(const LAS f32x4*)(ShL + col), sh1 = *(const LAS f32x4*)(ShL + col + 4);
                    const f32x4 v0 = (xn[r][2 * j] * rstd) * gp0 + sh0, v1 = (xn[r][2 * j + 1] * rstd) * gp1 + sh1;
                    v4u hw, lw; hw.x = cvt2(v0.x, v0.y); hw.y = cvt2(v0.z, v0.w); hw.z = cvt2(v1.x, v1.y); hw.w = cvt2(v1.z, v1.w);
                    lw.x = cvt2(v0.x - bflo(hw.x), v0.y - bfhi(hw.x)); lw.y = cvt2(v0.z - bflo(hw.y), v0.w - bfhi(hw.y)); lw.z = cvt2(v1.x - bflo(hw.z), v1.y - bfhi(hw.z)); lw.w = cvt2(v1.z - bflo(hw.w), v1.w - bfhi(hw.w));
                    if (ok) o8[64 * j] = hw;
                    *(LAS v4u*)(hH + lo + 512 * j) = hw; *(LAS v4u*)(hL + lo + 512 * j) = lw; }
            }
            const int m1 = m0 + 16;
            if (p0 + 16 < TPB && m1 < T) {
#pragma unroll
                for (int r = 0; r < 2; ++r) { const float* xr = c.x + (size_t)(m1 + r) * D + 8 * lane;
#pragma unroll
                    for (int j = 0; j < 4; ++j) { xn[r][2 * j] = *(const f32x4*)(xr + 512 * j); xn[r][2 * j + 1] = *(const f32x4*)(xr + 512 * j + 4); } } }
        }
        __syncthreads();
        {
            f32x4 aHH = {0.f, 0.f, 0.f, 0.f}, aHL = {0.f, 0.f, 0.f, 0.f}, aLH = {0.f, 0.f, 0.f, 0.f};
            const int ao = fi * RSB + 256 * w + 8 * kq;
#pragma unroll
            for (int s2 = 0; s2 < 8; ++s2) {
                const bf16x8 ah = *(const LAS bf16x8*)(hH + ao + 32 * s2), al = *(const LAS bf16x8*)(hL + ao + 32 * s2);
                aHH = __builtin_amdgcn_mfma_f32_16x16x32_bf16(ah, wbH[s2], aHH, 0, 0, 0); aHL = __builtin_amdgcn_mfma_f32_16x16x32_bf16(ah, wbL[s2], aHL, 0, 0, 0); aLH = __builtin_amdgcn_mfma_f32_16x16x32_bf16(al, wbH[s2], aLH, 0, 0, 0);
            }
            *(LAS f32x4*)(part + (w * 64 + lane) * 4) = aHH + (aHL + aLH);
        }
        __syncthreads();
        if (c.tid < 256) {
            const int i = c.tid >> 4, n = c.tid & 15; float sacc = 0.f;
            const LAS float* pp = part + ((i >> 2) * 16 + n) * 4 + (i & 3);
#pragma unroll
            for (int ww = 0; ww < 8; ++ww) sacc += pp[ww * 256];
            if (base + p0 + i < T) c.ba[(size_t)(base + p0 + i) * 16 + n] = sacc;
        }
    }
}

template <class ARow, class BRow, class Epi>
__device__ __forceinline__ void naive_gemm(const Ctx& c, int nMt, int nNt, int K, const ARow& arow, const BRow& brow, const Epi& epi) {
    LAS float* As = (LAS float*)c.lds;
    LAS float* Bs = As + 32 * 68;
    const int tid = c.tid, ty = tid >> 5, tx = tid & 31;
    for (int u = c.bid; u < nMt * nNt; u += c.G) {
        const int mt = u / nNt, nt = u % nNt;
        float acc[4][8];
#pragma unroll
        for (int r = 0; r < 4; ++r)
#pragma unroll
            for (int i = 0; i < 8; ++i) acc[r][i] = 0.f;
        for (int k0 = 0; k0 < K; k0 += 32) {
            if (tid < 256) { const int r = tid >> 2, kc = (tid & 3) * 8; const v4u w = *(const v4u*)(arow(mt * 64 + r) + k0 + kc);
                As[(kc + 0) * 68 + r] = bflo(w.x); As[(kc + 1) * 68 + r] = bfhi(w.x); As[(kc + 2) * 68 + r] = bflo(w.y); As[(kc + 3) * 68 + r] = bfhi(w.y);
                As[(kc + 4) * 68 + r] = bflo(w.z); As[(kc + 5) * 68 + r] = bfhi(w.z); As[(kc + 6) * 68 + r] = bflo(w.w); As[(kc + 7) * 68 + r] = bfhi(w.w); }
            { const int n = tid >> 1, kc = (tid & 1) * 16; const bf16* bp = brow(mt, nt * 256 + n) + k0 + kc; const v4u w0 = *(const v4u*)bp, w1 = *(const v4u*)(bp + 8);
                LAS float* d = Bs + kc * 260 + n;
                d[0 * 260] = bflo(w0.x); d[1 * 260] = bfhi(w0.x); d[2 * 260] = bflo(w0.y); d[3 * 260] = bfhi(w0.y); d[4 * 260] = bflo(w0.z); d[5 * 260] = bfhi(w0.z); d[6 * 260] = bflo(w0.w); d[7 * 260] = bfhi(w0.w);
                d[8 * 260] = bflo(w1.x); d[9 * 260] = bfhi(w1.x); d[10 * 260] = bflo(w1.y); d[11 * 260] = bfhi(w1.y); d[12 * 260] = bflo(w1.z); d[13 * 260] = bfhi(w1.z); d[14 * 260] = bflo(w1.w); d[15 * 260] = bfhi(w1.w); }
            __syncthreads();
#pragma unroll 4
            for (int kk = 0; kk < 32; ++kk) { const f32x4 a = *(const LAS f32x4*)(As + kk * 68 + 4 * ty); float bv[8];
#pragma unroll
                for (int i = 0; i < 8; ++i) bv[i] = Bs[kk * 260 + tx + 32 * i];
#pragma unroll
                for (int i = 0; i < 8; ++i) { acc[0][i] += a.x * bv[i]; acc[1][i] += a.y * bv[i]; acc[2][i] += a.z * bv[i]; acc[3][i] += a.w * bv[i]; } }
            __syncthreads();
        }
#pragma unroll
        for (int r = 0; r < 4; ++r) epi(mt * 64 + 4 * ty + r, nt * 256, tx, acc[r]);
    }
}

__device__ __forceinline__ void naive_gdn(const Ctx& c, int b, int h) {
    LAS float* sq = (LAS float*)c.lds;
    LAS float* red = sq + 384;
    LAS float* nrm = red + 512;
    const int tid = c.tid, v = tid & 127, dq = tid >> 7;
    float S[32];
#pragma unroll
    for (int i = 0; i < 32; ++i) S[i] = 0.f;
    const float A = expf(c.a_log[h]), dtb = c.dt_bias[h];
    for (int t = 0; t < SEQ; ++t) {
        const size_t row = (size_t)b * SEQ + t;
        if (tid < 384) { const int mat = tid >> 7, ch = tid & 127, col = mat * 1024 + h * 128 + ch; float a = 0.f;
#pragma unroll
            for (int i = 0; i < 4; ++i) { const int tt = t - 3 + i; if (tt >= 0) a += c.conv_w[i * 3072 + col] * bf2f(c.PROJ[((size_t)b * SEQ + tt) * NPROJ + col]); }
            sq[tid] = siluf(a); }
        __syncthreads();
        if (c.wave < 2) { const float a0 = sq[c.wave * 128 + c.lane], a1 = sq[c.wave * 128 + 64 + c.lane]; const float s = wave_sum(a0 * a0 + a1 * a1); if (c.lane == 0) nrm[c.wave] = s; }
        __syncthreads();
        const float rq = rsqrtf(nrm[0] + EPS) * 0.08838834764831845f, rk = rsqrtf(nrm[1] + EPS);
        const float beta = sigmoidf_(c.ba[row * 16 + h]), gs = -A * softplusf_(c.ba[row * 16 + 8 + h] + dtb), a = expf(gs);
        float p = 0.f;
#pragma unroll
        for (int i = 0; i < 32; ++i) p += sq[128 + 32 * dq + i] * rk * S[i];
        red[dq * 128 + v] = p;
        __syncthreads();
        const float kS = (red[v] + red[128 + v]) + (red[256 + v] + red[384 + v]);
        const float vv = sq[256 + v];
        __syncthreads();
        float po = 0.f;
#pragma unroll
        for (int i = 0; i < 32; ++i) { const float kd = sq[128 + 32 * dq + i] * rk; S[i] = a * (S[i] - beta * kd * kS) + beta * kd * vv; po += sq[32 * dq + i] * rq * S[i]; }
        red[dq * 128 + v] = po;
        __syncthreads();
        if (dq == 0) c.O[row * D + h * 128 + v] = (red[v] + red[128 + v]) + (red[256 + v] + red[384 + v]);
        __syncthreads();
    }
}
__device__ __forceinline__ void naive_ret(const Ctx& c, int b, int h, int vh) {
    LAS float* sq = (LAS float*)c.lds;
    LAS float* red = sq + 640;
    const int tid = c.tid, v = tid & 127, dq = tid >> 7;
    float S[64];
#pragma unroll
    for (int i = 0; i < 64; ++i) S[i] = 0.f;
    const float gamma = 1.f - exp2f(-5.f - (float)h);
    for (int t = 0; t < SEQ; ++t) {
        const size_t row = (size_t)b * SEQ + t;
        if (tid < 256) { const int mat = tid >> 7, i = tid & 127; const int colb = 4096 + mat * 1024 + h * 256;
            const float x1 = bf2f(c.PROJ[row * NPROJ + colb + i]), x2 = bf2f(c.PROJ[row * NPROJ + colb + 128 + i]);
            const float invf = powf(10000.f, -(float)i / 127.f), ang = (float)c.positions[row] * invf; const float cs = cosf(ang), sn = sinf(ang);
            const float sc = mat ? 0.0625f : 1.f;
            sq[mat * 256 + i] = (x1 * cs - x2 * sn) * sc; sq[mat * 256 + 128 + i] = (x2 * cs + x1 * sn) * sc; }
        else if (tid < 384) { const int i = tid - 256; sq[512 + i] = bf2f(c.PROJ[row * NPROJ + 6144 + h * 256 + vh * 128 + i]); }
        __syncthreads();
        const float vv = sq[512 + v]; float po = 0.f;
#pragma unroll
        for (int i = 0; i < 64; ++i) { S[i] = gamma * S[i] + sq[256 + 64 * dq + i] * vv; po += sq[64 * dq + i] * S[i]; }
        red[dq * 128 + v] = po;
        __syncthreads();
        if (dq == 0) c.O[row * D + 1024 + h * 256 + vh * 128 + v] = (red[v] + red[128 + v]) + (red[256 + v] + red[384 + v]);
        __syncthreads();
    }
}
__device__ __forceinline__ void ph_mixer_naive(const Ctx& c) {
    for (int u = c.bid; u < 64; u += c.G) {
        if (u < 32) naive_gdn(c, u >> 3, u & 7);
        else { const int r = u - 32; naive_ret(c, r >> 3, (r >> 1) & 3, r & 1); }
    }
}

__device__ __forceinline__ void ph_gatenorm(const Ctx& c) {
    const int gw = c.bid * NWAVES + c.wave, NGW = c.G * NWAVES;
    v4u ow[4], zw[4];
    auto fetch = [&](int m, v4u (&o)[4], v4u (&z)[4]) {
        const v4u* orow = (const v4u*)(c.Ob + (size_t)m * D) + c.lane; const bf16* prow = c.PROJ + (size_t)m * NPROJ + 8 * c.lane;
#pragma unroll
        for (int j = 0; j < 4; ++j) { o[j] = orow[64 * j]; z[j] = *(const v4u*)(prow + (j < 2 ? 3072 + 512 * j : 7168 + 512 * (j - 2))); } };
    if (gw < T) fetch(gw, ow, zw);
    for (int m = gw; m < T; m += NGW) {
        v4u on[4], zn[4];
        const bool more = m + NGW < T;
        if (more) fetch(m + NGW, on, zn);
        v4u* o8 = (v4u*)(c.H + (size_t)m * D) + c.lane;
#pragma unroll
        for (int j = 0; j < 4; ++j) {
            const int col = 8 * c.lane + 512 * j;
            const f32x4 oa = {bflo(ow[j].x), bfhi(ow[j].x), bflo(ow[j].y), bfhi(ow[j].y)}, ob = {bflo(ow[j].z), bfhi(ow[j].z), bflo(ow[j].w), bfhi(ow[j].w)};
            const f32x4 za = {bflo(zw[j].x), bfhi(zw[j].x), bflo(zw[j].y), bfhi(zw[j].y)}, zb = {bflo(zw[j].z), bfhi(zw[j].z), bflo(zw[j].w), bfhi(zw[j].w)};
            f32x4 ra, rb;
            if (j < 2) {
                float ss = ((oa.x * oa.x + oa.y * oa.y) + (oa.z * oa.z + oa.w * oa.w)) + ((ob.x * ob.x + ob.y * ob.y) + (ob.z * ob.z + ob.w * ob.w));
#pragma unroll
                for (int s2 = 1; s2 < 16; s2 <<= 1) ss += __shfl_xor(ss, s2);
                const float rstd = rsqrtf(ss * (1.f / 128.f) + EPS);
                const f32x4 ga = *(const f32x4*)(c.gdn_norm_g + (col & 127)), gb = *(const f32x4*)(c.gdn_norm_g + (col & 127) + 4);
                ra.x = oa.x * rstd * ga.x * siluf(za.x); ra.y = oa.y * rstd * ga.y * siluf(za.y); ra.z = oa.z * rstd * ga.z * siluf(za.z); ra.w = oa.w * rstd * ga.w * siluf(za.w);
                rb.x = ob.x * rstd * gb.x * siluf(zb.x); rb.y = ob.y * rstd * gb.y * siluf(zb.y); rb.z = ob.z * rstd * gb.z * siluf(zb.z); rb.w = ob.w * rstd * gb.w * siluf(zb.w);
            } else {
                float sm = ((oa.x + oa.y) + (oa.z + oa.w)) + ((ob.x + ob.y) + (ob.z + ob.w));
#pragma unroll
                for (int s2 = 1; s2 < 32; s2 <<= 1) sm += __shfl_xor(sm, s2);
                const float mu = sm * (1.f / 256.f);
                const f32x4 da = oa - mu, db = ob - mu;
                float vs = ((da.x * da.x + da.y * da.y) + (da.z * da.z + da.w * da.w)) + ((db.x * db.x + db.y * db.y) + (db.z * db.z + db.w * db.w));
#pragma unroll
                for (int s2 = 1; s2 < 32; s2 <<= 1) vs += __shfl_xor(vs, s2);
                const float rstd = rsqrtf(vs * (1.f / 256.f) + EPS);
                const int cc = col - 1024;
                const f32x4 ga = *(const f32x4*)(c.ret_norm_g + cc), gb = *(const f32x4*)(c.ret_norm_g + cc + 4), ba = *(const f32x4*)(c.ret_norm_b + cc), bb = *(const f32x4*)(c.ret_norm_b + cc + 4);
                ra.x = (da.x * rstd * ga.x + ba.x) * siluf(za.x); ra.y = (da.y * rstd * ga.y + ba.y) * siluf(za.y); ra.z = (da.z * rstd * ga.z + ba.z) * siluf(za.z); ra.w = (da.w * rstd * ga.w + ba.w) * siluf(za.w);
                rb.x = (db.x * rstd * gb.x + bb.x) * siluf(zb.x); rb.y = (db.y * rstd * gb.y + bb.y) * siluf(zb.y); rb.z = (db.z * rstd * gb.z + bb.z) * siluf(zb.z); rb.w = (db.w * rstd * gb.w + bb.w) * siluf(zb.w);
            }
            v4u w; w.x = pk2(ra.x, ra.y); w.y = pk2(ra.z, ra.w); w.z = pk2(rb.x, rb.y); w.w = pk2(rb.z, rb.w); o8[64 * j] = w;
        }
        if (more) {
#pragma unroll
            for (int j = 0; j < 4; ++j) { ow[j] = on[j]; zw[j] = zn[j]; } }
    }
}

__device__ __forceinline__ int tokens_per_block(int G) { return (((T + G - 1) / G) + 15) & ~15; }
__device__ __forceinline__ void ph_router(const Ctx& c) {
    constexpr int RSB = 2056;
    LAS bf16* hH = (LAS bf16*)c.lds;
    LAS bf16* hL = hH + 16 * RSB;
    LAS float* part = (LAS float*)(c.lds + 2 * 16 * RSB * 2);
    LAS float* GpL = part + 2048;
    LAS float* ShL = GpL + 2048;
    LAS int* hist = (LAS int*)(ShL + 2048);
    if (c.tid < 32) hist[c.tid] = 0;
    const int TPB = tokens_per_block(c.G), base = c.bid * TPB;
    const int lane = c.lane, w = c.wave, fi = lane & 15, kq = lane >> 4, ks = w >> 1, nt = w & 1;
    if (base >= T) { __syncthreads(); if (c.tid < 32) c.blk_cnt[c.bid * 32 + c.tid] = 0; return; }
    v2u xn[2][8];
    { const int m0 = base + 2 * w; const int mr = m0 < T ? m0 : 0;
#pragma unroll
      for (int r = 0; r < 2; ++r) { const v2u* xr = (const v2u*)(c.X1 + (size_t)(mr + r) * D) + lane;
#pragma unroll
          for (int j = 0; j < 8; ++j) xn[r][j] = xr[64 * j]; } }
    const float brt = c.b_router[c.tid & 31];
    bf16x8 wrH[16], wrL[16];
    { const float* bp = c.wr_t + (size_t)(16 * nt + fi) * D + 512 * ks + 8 * kq;
#pragma unroll
      for (int s2 = 0; s2 < 16; ++s2) { const f32x4 f0 = *(const f32x4*)(bp + 32 * s2), f1 = *(const f32x4*)(bp + 32 * s2 + 4);
          const unsigned h0 = cvt2(f0.x, f0.y), h1 = cvt2(f0.z, f0.w), h2 = cvt2(f1.x, f1.y), h3 = cvt2(f1.z, f1.w);
          const unsigned l0 = cvt2(f0.x - bflo(h0), f0.y - bfhi(h0)), l1 = cvt2(f0.z - bflo(h1), f0.w - bfhi(h1)), l2 = cvt2(f1.x - bflo(h2), f1.y - bfhi(h2)), l3 = cvt2(f1.z - bflo(h3), f1.w - bfhi(h3));
          wrH[s2] = __builtin_bit_cast(bf16x8, (v4u){h0, h1, h2, h3}); wrL[s2] = __builtin_bit_cast(bf16x8, (v4u){l0, l1, l2, l3}); } }
    int cbat = -1;
    for (int p0 = 0; p0 < TPB; p0 += 16) {
        if (base + p0 >= T) break;
        const int bat = (base + p0) >> 12;
        if (bat != cbat) {
            cbat = bat; __syncthreads();
            const float* mb = c.mod + bat * MODW; const int col = 4 * c.tid;
            const f32x4 g = *(const f32x4*)(c.norm2_g + col), sc = *(const f32x4*)(mb + 4 * D + col), sh = *(const f32x4*)(mb + 3 * D + col);
            *(LAS f32x4*)(GpL + col) = g * (1.f + sc); *(LAS f32x4*)(ShL + col) = sh;
            __syncthreads();
        }
        {
            const int m0 = base + p0 + 2 * w;
            const bool ok = m0 < T;
            const int mr = ok ? m0 : 0;
#pragma unroll
            for (int r = 0; r < 2; ++r) {
                f32x4 h[8]; float ss = 0.f;
#pragma unroll
                for (int j = 0; j < 8; ++j) { h[j] = (f32x4){bflo(xn[r][j].x), bfhi(xn[r][j].x), bflo(xn[r][j].y), bfhi(xn[r][j].y)};
                    ss += (h[j].x * h[j].x + h[j].y * h[j].y) + (h[j].z * h[j].z + h[j].w * h[j].w); }
                const float rstd = rsqrtf(wave_sum(ss) * (1.f / D) + EPS);
                unsigned* o4 = (unsigned*)(c.H8 + (size_t)(mr + r) * D) + lane; const int lo = (2 * w + r) * RSB + 4 * lane;
#pragma unroll
                for (int j = 0; j < 8; ++j) { const f32x4 gp = *(const LAS f32x4*)(GpL + 4 * lane + 256 * j), sh = *(const LAS f32x4*)(ShL + 4 * lane + 256 * j);
                    const f32x4 v = (h[j] * rstd) * gp + sh;
                    if (ok) o4[64 * j] = pk4_fp8(v.x, v.y, v.z, v.w);
                    v2u hw, lw; hw.x = cvt2(v.x, v.y); hw.y = cvt2(v.z, v.w);
                    lw.x = cvt2(v.x - bflo(hw.x), v.y - bfhi(hw.x)); lw.y = cvt2(v.z - bflo(hw.y), v.w - bfhi(hw.y));
                    *(LAS v2u*)(hH + lo + 256 * j) = hw; *(LAS v2u*)(hL + lo + 256 * j) = lw; }
            }
            const int m1 = m0 + 16;
            if (p0 + 16 < TPB && m1 < T) {
#pragma unroll
                for (int r = 0; r < 2; ++r) { const v2u* xr = (const v2u*)(c.X1 + (size_t)(m1 + r) * D) + lane;
#pragma unroll
                    for (int j = 0; j < 8; ++j) xn[r][j] = xr[64 * j]; } }
        }
        __syncthreads();
        {
            f32x4 aHH = {0.f, 0.f, 0.f, 0.f}, aHL = {0.f, 0.f, 0.f, 0.f}, aLH = {0.f, 0.f, 0.f, 0.f};
            const int ao = fi * RSB + 512 * ks + 8 * kq;
#pragma unroll
            for (int s2 = 0; s2 < 16; ++s2) {
                const bf16x8 ah = *(const LAS bf16x8*)(hH + ao + 32 * s2), al = *(const LAS bf16x8*)(hL + ao + 32 * s2);
                aHH = __builtin_amdgcn_mfma_f32_16x16x32_bf16(ah, wrH[s2], aHH, 0, 0, 0); aHL = __builtin_amdgcn_mfma_f32_16x16x32_bf16(ah, wrL[s2], aHL, 0, 0, 0); aLH = __builtin_amdgcn_mfma_f32_16x16x32_bf16(al, wrH[s2], aLH, 0, 0, 0);
            }
            *(LAS f32x4*)(part + ((ks * 2 + nt) * 64 + lane) * 4) = aHH + (aHL + aLH);
        }
        __syncthreads();
        {
            const int i = c.tid >> 5, e_me = c.tid & 31, m = base + p0 + i;
            float val = brt;
            const LAS float* pp = part + (((e_me >> 4) * 64) + ((i >> 2) * 16 + (e_me & 15))) * 4 + (i & 3);
#pragma unroll
            for (int ww = 0; ww < 4; ++ww) val += pp[ww * 2 * 64 * 4];
            float selv[4]; int seli[4];
#pragma unroll
            for (int k = 0; k < 4; ++k) {
                float mx = val; int idx = e_me;
#pragma unroll
                for (int off = 16; off >= 1; off >>= 1) { const float om = __shfl_xor(mx, off); const int oi = __shfl_xor(idx, off); if (om > mx || (om == mx && oi < idx)) { mx = om; idx = oi; } }
                selv[k] = mx; seli[k] = idx; if (e_me == idx) val = -INFINITY;
            }
            const float e1 = expf(selv[1] - selv[0]), e2 = expf(selv[2] - selv[0]), e3 = expf(selv[3] - selv[0]); const float inv = 1.f / (1.f + e1 + e2 + e3);
            if (e_me == 0 && m < T) {
                c.tok_e[m * 4 + 0] = seli[0]; c.tok_e[m * 4 + 1] = seli[1]; c.tok_e[m * 4 + 2] = seli[2]; c.tok_e[m * 4 + 3] = seli[3];
                c.tok_g[m * 4 + 0] = inv; c.tok_g[m * 4 + 1] = e1 * inv; c.tok_g[m * 4 + 2] = e2 * inv; c.tok_g[m * 4 + 3] = e3 * inv;
                lds_inc(&hist[seli[0]]); lds_inc(&hist[seli[1]]); lds_inc(&hist[seli[2]]); lds_inc(&hist[seli[3]]); }
        }
    }
    __syncthreads();
    if (c.tid < 32) c.blk_cnt[c.bid * 32 + c.tid] = hist[c.tid];
}

__device__ __forceinline__ void ph_route2(const Ctx& c) {
    LAS int* part_all = (LAS int*)c.lds;
    LAS int* part_bef = part_all + 512;
    LAS int* tot = part_bef + 512;
    LAS int* bas = tot + 32;
    LAS int* pst = bas + 32;
    LAS int* ent = pst + 64;
    const int TPB = tokens_per_block(c.G), base = c.bid * TPB, nent = TPB * 4;
    LAS int* posl = ent + nent;
    { const int e = c.tid & 31, part = c.tid >> 5; int sa = 0, sb = 0;
      for (int bb = part; bb < c.G; bb += 16) { const int v = c.blk_cnt[bb * 32 + e]; sa += v; if (bb < c.bid) sb += v; }
      part_all[part * 32 + e] = sa; part_bef[part * 32 + e] = sb; }
    __syncthreads();
    if (c.tid < 32) { int sa = 0, sb = 0;
#pragma unroll
        for (int p = 0; p < 16; ++p) { sa += part_all[p * 32 + c.tid]; sb += part_bef[p * 32 + c.tid]; }
        tot[c.tid] = sa; bas[c.tid] = sb; }
    __syncthreads();
    if (c.tid == 0) { int p = 0; for (int e = 0; e < 32; ++e) { pst[e] = p; p += (tot[e] + 255) & ~255; } pst[32] = p; }
    for (int i = c.tid; i < nent; i += NTHREADS) { const int tok = base + (i >> 2); ent[i] = tok < T ? c.tok_e[tok * 4 + (i & 3)] : -1; }
    __syncthreads();
    for (int i = c.tid; i < nent; i += NTHREADS) {
        const int e = ent[i]; int pos = -1;
        if (e >= 0) { int rank = 0; for (int j = 0; j < i; ++j) rank += (ent[j] == e) ? 1 : 0;
            pos = pst[e] + bas[e] + rank; const int tok = base + (i >> 2);
            c.tok_pos[tok * 4 + (i & 3)] = pos; c.row_gate[pos] = c.tok_g[tok * 4 + (i & 3)]; c.row_tok[pos] = tok; }
        posl[i] = pos;
    }
    __syncthreads();
    for (int i0 = 4 * c.wave; i0 < nent; i0 += 4 * NWAVES) {
        v4u v[4][2]; int ps[4];
#pragma unroll
        for (int k = 0; k < 4; ++k) { const int i = i0 + k; ps[k] = (i < nent) ? posl[i] : -1; const int tok = base + (i >> 2);
            const v4u* src = (const v4u*)(c.H8 + (size_t)(ps[k] >= 0 ? tok : 0) * D) + c.lane; v[k][0] = src[0]; v[k][1] = src[64]; }
#pragma unroll
        for (int k = 0; k < 4; ++k) if (ps[k] >= 0) { v4u* dst = (v4u*)(c.XS8 + (size_t)ps[k] * D) + c.lane; dst[0] = v[k][0]; dst[64] = v[k][1]; }
    }
    if (c.bid == 0) {
        const int nmt = pst[32] >> 8;
        for (int mt = c.tid; mt < nmt; mt += NTHREADS) { int e = 0; while (e < 31 && pst[e + 1] <= mt * 256) ++e; c.tile_e[mt] = e; }
        if (c.tid == 0) c.meta[0] = nmt;
    }
}

__device__ __forceinline__ void ph_final(const Ctx& c) {
    const int gw = c.bid * NWAVES + c.wave, NGW = c.G * NWAVES;
    for (int m = gw; m < T; m += NGW) {
        const int b = m >> 12;
        const float* gt2 = c.mod + b * MODW + 5 * D;
        const v4u* xr = (const v4u*)(c.X1 + (size_t)m * D) + c.lane;
        int pos[4];
#pragma unroll
        for (int k = 0; k < 4; ++k) pos[k] = c.tok_pos[m * 4 + k];
        f32x4 v[8]; float ss = 0.f;
#pragma unroll
        for (int j = 0; j < 4; ++j) {
            const int col = 8 * c.lane + 512 * j; f32x4 y0 = {0.f, 0.f, 0.f, 0.f}, y1 = {0.f, 0.f, 0.f, 0.f};
#pragma unroll
            for (int k = 0; k < 4; ++k) { const v4u w = __builtin_nontemporal_load((const v4u*)(c.Y + (size_t)pos[k] * D) + c.lane + 64 * j);
                y0.x += bflo(w.x); y0.y += bfhi(w.x); y0.z += bflo(w.y); y0.w += bfhi(w.y); y1.x += bflo(w.z); y1.y += bfhi(w.z); y1.z += bflo(w.w); y1.w += bfhi(w.w); }
            const f32x4 g0 = *(const f32x4*)(gt2 + col), g1 = *(const f32x4*)(gt2 + col + 4);
            const v4u xw = xr[64 * j]; const f32x4 x0 = {bflo(xw.x), bfhi(xw.x), bflo(xw.y), bfhi(xw.y)}, x1 = {bflo(xw.z), bfhi(xw.z), bflo(xw.w), bfhi(xw.w)};
            v[2 * j] = x0 + g0 * y0; v[2 * j + 1] = x1 + g1 * y1;
            ss += ((v[2 * j].x * v[2 * j].x + v[2 * j].y * v[2 * j].y) + (v[2 * j].z * v[2 * j].z + v[2 * j].w * v[2 * j].w))
                + ((v[2 * j + 1].x * v[2 * j + 1].x + v[2 * j + 1].y * v[2 * j + 1].y) + (v[2 * j + 1].z * v[2 * j + 1].z + v[2 * j + 1].w * v[2 * j + 1].w));
        }
        const float rstd = rsqrtf(wave_sum(ss) * (1.f / D) + EPS);
        float* orow = c.out + (size_t)m * D + 8 * c.lane;
#pragma unroll
        for (int j = 0; j < 4; ++j) { const f32x4 g0 = *(const f32x4*)(c.final_g + 8 * c.lane + 512 * j), g1 = *(const f32x4*)(c.final_g + 8 * c.lane + 512 * j + 4);
            __builtin_nontemporal_store(v[2 * j] * rstd * g0, (f32x4*)(orow + 512 * j)); __builtin_nontemporal_store(v[2 * j + 1] * rstd * g1, (f32x4*)(orow + 512 * j + 4)); }
    }
}

struct ARowDense { const bf16* A; __device__ __forceinline__ const bf16* operator()(int row) const { return A + (size_t)row * D; } };
struct BRowDense { const bf16* Bt; __device__ __forceinline__ const bf16* operator()(int, int n) const { return Bt + (size_t)n * D; } };
struct BRowExpert { const bf16* Bt; const int* tile_e; int N; __device__ __forceinline__ const bf16* operator()(int mt64, int n) const { return Bt + ((size_t)tile_e[mt64 >> 2] * N + n) * D; } };
struct NEpiProj { bf16* O; __device__ __forceinline__ void operator()(int row, int cb, int tx, const float (&v)[8]) const {
#pragma unroll
        for (int i = 0; i < 8; ++i) O[(size_t)row * NPROJ + cb + tx + 32 * i] = (bf16)f2bf(v[i]); } };
struct NEpiResid { const float* x; const float* mod; bf16* X1; __device__ __forceinline__ void operator()(int row, int cb, int tx, const float (&v)[8]) const {
        const float* gt1 = mod + (row >> 12) * MODW + 2 * D;
#pragma unroll
        for (int i = 0; i < 8; ++i) { const int n = cb + tx + 32 * i; X1[(size_t)row * D + n] = (bf16)f2bf(x[(size_t)row * D + n] + gt1[n] * v[i]); } } };
__device__ __forceinline__ float swiglu(float g, float l) { g = fminf(g, 7.f); l = __builtin_amdgcn_fmed3f(l, -7.f, 7.f); return (g * __builtin_amdgcn_rcpf(1.f + __builtin_amdgcn_exp2f(-2.4554669595930156f * g))) * (l + 1.f); }
struct NEpiUp { bf16* ACT; const float* b1; const int* tile_e; __device__ __forceinline__ void operator()(int row, int cb, int tx, const float (&v)[8]) const {
        const int e = tile_e[row >> 8];
#pragma unroll
        for (int i = 0; i < 4; ++i) { const int f = (cb >> 8) * 128 + tx + 32 * i; const float g = v[i] + b1[e * 4096 + f], l = v[i + 4] + b1[e * 4096 + 2048 + f]; ACT[(size_t)row * D + f] = (bf16)f2bf(swiglu(g, l)); } } };
struct NEpiDown { bf16* Y; const float* b2; const int* tile_e; const float* row_gate; __device__ __forceinline__ void operator()(int row, int cb, int tx, const float (&v)[8]) const {
        const int e = tile_e[row >> 8]; const float gt = row_gate[row];
#pragma unroll
        for (int i = 0; i < 8; ++i) { const int n = cb + tx + 32 * i; Y[(size_t)row * D + n] = (bf16)f2bf((v[i] + b2[e * D + n]) * gt); } } };

namespace pg8 {
constexpr int BM = 256, BK = 64, HALF = 128, HTB = HALF * BK * 2, STAGE_BYTES = 8 * HTB, NXCD = 8, WGM = 8;
constexpr int K = D;
__host__ __device__ __forceinline__ int lds_byte(int r, int c) { const int st = (r >> 4) * 2 + (c >> 5), rr = r & 15, cc = c & 31, ob = rr * 64 + cc * 2; return st * 1024 + (ob ^ (((ob >> 9) & 1) << 5)); }
__host__ __device__ __forceinline__ void stage_rc(int b, int& R, int& C) { const int st = b / 1024, sb = b % 1024, swz = sb ^ (((sb >> 9) & 1) << 5); R = (st >> 1) * 16 + swz / 64; C = (st & 1) * 32 + (swz % 64) / 2; }
__host__ __device__ __forceinline__ int perm32(int rho) { const int n = rho >> 4, i = rho & 15; return 8 * (i >> 2) + 4 * n + (i & 3); }
struct Unit { int pm, pn; };
struct Sched {
    const void* A; const void* Bt; const int* tile_e; int N; int nM, nN, nwg, G, c; size_t rb;
    __device__ void init(const void* A_, const void* Bt_, const int* te, int nM_, int N_, int G_, int c_, size_t rb_) { A = A_; Bt = Bt_; tile_e = te; N = N_; nM = nM_; nN = N_ / BM; nwg = nM * nN; G = G_; c = c_; rb = rb_; }
    __device__ __forceinline__ bool next(int i, Unit& u) const {
        const long L = (long)i * G + c; if (L >= nwg) return false;
        int wgid = (int)L; { const int q = nwg / NXCD, r = nwg % NXCD, xcd = wgid % NXCD, off = wgid / NXCD; wgid = (xcd < r ? xcd * (q + 1) : r * (q + 1) + (xcd - r) * q) + off; }
        const int nig = WGM * nN, gid = wgid / nig, fm = gid * WGM, gsz = (nM - fm) < WGM ? (nM - fm) : WGM;
        u.pm = fm + ((wgid % nig) % gsz); u.pn = (wgid % nig) / gsz; return true;
    }
    __device__ __forceinline__ const char* a_base(const Unit& u) const { return (const char*)A + (size_t)u.pm * ((size_t)BM * rb); }
    __device__ __forceinline__ const char* b_base(const Unit& u) const { const size_t e = tile_e ? (size_t)__builtin_amdgcn_readfirstlane(tile_e[u.pm]) : 0; return (const char*)Bt + (e * N + (size_t)u.pn * BM) * rb; }
};
__device__ __forceinline__ unsigned cvt_pk_bf16(float lo, float hi) { unsigned r; asm volatile("v_cvt_pk_bf16_f32 %0, %1, %2" : "=v"(r) : "v"(lo), "v"(hi)); return r; }
struct EpiProj {
    static constexpr bool PERM = true;
    bf16* O; int ldc;
    __device__ __forceinline__ void operator()(const f32x4 (&acc)[2][2][4][2], const Unit& u, int wr, int wc, int fr, int fq) const {
        const int row0 = u.pm * BM + wr * 64 + fr, col0 = u.pn * BM + wc * 32 + 8 * fq;
#pragma unroll
        for (int ai = 0; ai < 2; ++ai)
#pragma unroll
            for (int m = 0; m < 4; ++m) { bf16* rowp = O + (size_t)(row0 + ai * HALF + m * 16) * ldc + col0;
#pragma unroll
                for (int bj = 0; bj < 2; ++bj) { const f32x4 v0 = acc[ai][bj][m][0], v1 = acc[ai][bj][m][1];
                    v4u w; w.x = cvt_pk_bf16(v0[0], v0[1]); w.y = cvt_pk_bf16(v0[2], v0[3]); w.z = cvt_pk_bf16(v1[0], v1[1]); w.w = cvt_pk_bf16(v1[2], v1[3]);
                    *(v4u*)(rowp + bj * HALF) = w; } }
    }
};
struct EpiResid {
    static constexpr bool PERM = true;
    const float* x; const float* mod; bf16* X1;
    __device__ __forceinline__ void operator()(const f32x4 (&acc)[2][2][4][2], const Unit& u, int wr, int wc, int fr, int fq) const {
        const int row0 = u.pm * BM + wr * 64 + fr, col0 = u.pn * BM + wc * 32 + 8 * fq;
        const float* gt = mod + (u.pm >> 4) * MODW + 2 * D + col0;
        f32x4 gv[2][2];
#pragma unroll
        for (int bj = 0; bj < 2; ++bj)
#pragma unroll
            for (int n = 0; n < 2; ++n) gv[bj][n] = *(const f32x4*)(gt + bj * HALF + n * 4);
#pragma unroll
        for (int ai = 0; ai < 2; ++ai)
#pragma unroll
            for (int m = 0; m < 4; ++m) { const size_t off = (size_t)(row0 + ai * HALF + m * 16) * D + col0;
#pragma unroll
                for (int bj = 0; bj < 2; ++bj) { const f32x4 x0 = *(const f32x4*)(x + off + bj * HALF), x1 = *(const f32x4*)(x + off + bj * HALF + 4);
                    const f32x4 r0 = x0 + gv[bj][0] * acc[ai][bj][m][0], r1 = x1 + gv[bj][1] * acc[ai][bj][m][1];
                    v4u w; w.x = cvt2(r0[0], r0[1]); w.y = cvt2(r0[2], r0[3]); w.z = cvt2(r1[0], r1[1]); w.w = cvt2(r1[2], r1[3]);
                    *(v4u*)(X1 + off + bj * HALF) = w; }
                if (m == 3) asm volatile("" ::: "memory"); }
    }
};
struct EpiUp {
    static constexpr bool PERM = true;
    bf16* ACT; const float* b1; const int* tile_e;
    __device__ __forceinline__ void operator()(const f32x4 (&acc)[2][2][4][2], const Unit& u, int wr, int wc, int fr, int fq) const {
        const int e = tile_e[u.pm];
        const int row0 = u.pm * BM + wr * 64 + fr, f0 = u.pn * 128 + wc * 32 + 8 * fq;
        f32x4 bg[2], bl[2];
#pragma unroll
        for (int n = 0; n < 2; ++n) { bg[n] = *(const f32x4*)(b1 + (size_t)e * 4096 + f0 + 4 * n); bl[n] = *(const f32x4*)(b1 + (size_t)e * 4096 + 2048 + f0 + 4 * n); }
#pragma unroll
        for (int ai = 0; ai < 2; ++ai)
#pragma unroll
            for (int m = 0; m < 4; ++m) { bf16* rowp = ACT + (size_t)(row0 + ai * HALF + m * 16) * D + f0;
                f32x4 a[2];
#pragma unroll
                for (int n = 0; n < 2; ++n) { const f32x4 g = acc[ai][0][m][n] + bg[n], l = acc[ai][1][m][n] + bl[n];
                    a[n][0] = swiglu(g[0], l[0]); a[n][1] = swiglu(g[1], l[1]); a[n][2] = swiglu(g[2], l[2]); a[n][3] = swiglu(g[3], l[3]); }
                v4u w; w.x = cvt_pk_bf16(a[0][0], a[0][1]); w.y = cvt_pk_bf16(a[0][2], a[0][3]); w.z = cvt_pk_bf16(a[1][0], a[1][1]); w.w = cvt_pk_bf16(a[1][2], a[1][3]);
                *(v4u*)rowp = w; }
    }
};
struct EpiDown {
    static constexpr bool PERM = true;
    bf16* Y; const float* b2; const int* tile_e; const float* row_gate;
    __device__ __forceinline__ void operator()(const f32x4 (&acc)[2][2][4][2], const Unit& u, int wr, int wc, int fr, int fq) const {
        const int e = tile_e[u.pm];
        const int row0 = u.pm * BM + wr * 64 + fr, col0 = u.pn * BM + wc * 32 + 8 * fq;
        f32x4 bv[2][2];
#pragma unroll
        for (int bj = 0; bj < 2; ++bj)
#pragma unroll
            for (int n = 0; n < 2; ++n) bv[bj][n] = *(const f32x4*)(b2 + (size_t)e * D + col0 + bj * HALF + 4 * n);
#pragma unroll
        for (int ai = 0; ai < 2; ++ai)
#pragma unroll
            for (int m = 0; m < 4; ++m) { const int row = row0 + ai * HALF + m * 16; const float gt = row_gate[row]; bf16* rowp = Y + (size_t)row * D + col0;
#pragma unroll
                for (int bj = 0; bj < 2; ++bj) { const f32x4 v0 = (acc[ai][bj][m][0] + bv[bj][0]) * gt, v1 = (acc[ai][bj][m][1] + bv[bj][1]) * gt;
                    v4u w; w.x = cvt_pk_bf16(v0[0], v0[1]); w.y = cvt_pk_bf16(v0[2], v0[3]); w.z = cvt_pk_bf16(v1[0], v1[1]); w.w = cvt_pk_bf16(v1[2], v1[3]);
                    *(v4u*)(rowp + bj * HALF) = w; } }
    }
};

struct EpiUpF8 {
    static constexpr bool PERM = true;
    unsigned char* ACT; const float* b1; const int* tile_e;
    __device__ __forceinline__ void operator()(const f32x4 (&acc)[2][2][4][2], const Unit& u, int wr, int wc, int fr, int fq) const {
        const int e = tile_e[u.pm];
        const int row0 = u.pm * BM + wr * 64 + fr, f0 = u.pn * 128 + wc * 32 + 8 * fq;
        f32x4 bg[2], bl[2];
#pragma unroll
        for (int n = 0; n < 2; ++n) { bg[n] = *(const f32x4*)(b1 + (size_t)e * 4096 + f0 + 4 * n); bl[n] = *(const f32x4*)(b1 + (size_t)e * 4096 + 2048 + f0 + 4 * n); }
#pragma unroll
        for (int ai = 0; ai < 2; ++ai)
#pragma unroll
            for (int m = 0; m < 4; ++m) { unsigned char* rowp = ACT + (size_t)(row0 + ai * HALF + m * 16) * D + f0;
                v2u w;
#pragma unroll
                for (int n = 0; n < 2; ++n) { const f32x4 g = acc[ai][0][m][n] + bg[n], l = acc[ai][1][m][n] + bl[n];
                    const unsigned p = pk4_fp8_nc(swiglu(g[0], l[0]), swiglu(g[1], l[1]), swiglu(g[2], l[2]), swiglu(g[3], l[3])); if (n == 0) w.x = p; else w.y = p; }
                *(v2u*)rowp = w; }
    }
};
typedef int v8i __attribute__((ext_vector_type(8)));
template <class Epi>
__device__ __forceinline__ void gemm_phase_f8(LAS unsigned char* lds, const Sched& S, const Epi& E) {
    const int tid = threadIdx.x, wid = __builtin_amdgcn_readfirstlane(tid >> 6), lane = tid & 63, wr = wid >> 2, wc = wid & 3, fr = lane & 15, fq = lane >> 4;
    constexpr int KB = K;
    constexpr int nt = KB / 128;
    unsigned voffA[2], voffB[2];
#pragma unroll
    for (int i = 0; i < 2; ++i) { int R, C; stage_rc(tid * 16 + i * 8192, R, C); const int Rb = Epi::PERM ? ((R & ~31) + perm32(R & 31)) : R;
        voffA[i] = (unsigned)(R * KB + 2 * C); voffB[i] = (unsigned)(Rb * KB + 2 * C); }
    constexpr size_t kstep = 128;
    constexpr size_t hstep = (size_t)HALF * KB;
    const unsigned ldsw = (unsigned)wid * 1024u;
    const int aoff = lds_byte(wr * 64 + fr, fq * 16), boff = lds_byte(wc * 32 + fr, fq * 16);
#define PG8_SA(b, h) (((b) * 2 + (h)) * HTB)
#define PG8_SB(b, h) ((4 + (b) * 2 + (h)) * HTB)
#define PG8_STAGE(bufoff, gbase, voff) do { _Pragma("unroll") for (int _i = 0; _i < 2; ++_i) \
        __builtin_amdgcn_global_load_lds((const unsigned*)((const char*)(gbase) + (voff)[_i]), (LAS unsigned*)(lds + (bufoff) + ldsw + _i * 8192), 16, 0, 0); } while (0)
#define PG8_LD8(dst, off) do { const v4u _x = *(const LAS v4u*)(lds + (off)), _y = *(const LAS v4u*)(lds + (off) + 16); \
        dst = (v8i){(int)_x.x, (int)_x.y, (int)_x.z, (int)_x.w, (int)_y.x, (int)_y.y, (int)_y.z, (int)_y.w}; } while (0)
#define PG8_LDA(dst, b, h) do { _Pragma("unroll") for (int m = 0; m < 4; ++m) PG8_LD8(dst[m], PG8_SA(b, h) + aoff + m * 2048); } while (0)
#define PG8_LDB(dst, b, h) do { _Pragma("unroll") for (int n = 0; n < 2; ++n) PG8_LD8(dst[n], PG8_SB(b, h) + boff + n * 2048); } while (0)
#define PG8_MMA(ai, bj, At, Bt) do { __builtin_amdgcn_s_setprio(1); _Pragma("unroll") for (int m = 0; m < 4; ++m) _Pragma("unroll") for (int n = 0; n < 2; ++n) \
        asm volatile("v_mfma_scale_f32_16x16x128_f8f6f4 %0, %1, %2, %0, %3, %3 op_sel:[1,0,0] op_sel_hi:[0,0,0]" : "+v"(acc[ai][bj][m][n]) : "v"(Bt[n]), "v"(At[m]), "v"(sclv)); __builtin_amdgcn_s_setprio(0); } while (0)
#define PG8_WAIT_V(n) asm volatile("s_waitcnt vmcnt(" #n ")" ::: "memory")
#define PG8_WAIT_L(n) asm volatile("s_waitcnt lgkmcnt(" #n ")" ::: "memory")
#define PG8_BAR __builtin_amdgcn_s_barrier()
#define PG8_SCHED __builtin_amdgcn_sched_barrier(0)
    Unit cur, nxt; int ui = 0;
    if (!S.next(0, cur)) return;
    f32x4 acc[2][2][4][2];
#pragma unroll
    for (int a = 0; a < 2; ++a)
#pragma unroll
        for (int b = 0; b < 2; ++b)
#pragma unroll
            for (int m = 0; m < 4; ++m)
#pragma unroll
                for (int n = 0; n < 2; ++n) acc[a][b][m][n] = (f32x4){0.f, 0.f, 0.f, 0.f};
    v8i At[4], B0[2], B1[2];
    const int sclv = 0x0000777F;
    const char* cA = S.a_base(cur); const char* cB = S.b_base(cur);
    PG8_STAGE(PG8_SB(0, 0), cB, voffB); PG8_STAGE(PG8_SB(0, 1), cB + hstep, voffB); PG8_STAGE(PG8_SA(0, 0), cA, voffA); PG8_STAGE(PG8_SA(0, 1), cA + hstep, voffA);
    if (wr == 1) PG8_BAR;
    PG8_WAIT_V(2); PG8_BAR;
    PG8_STAGE(PG8_SB(1, 0), cB + kstep, voffB); PG8_STAGE(PG8_SA(1, 0), cA + kstep, voffA); PG8_STAGE(PG8_SB(1, 1), cB + hstep + kstep, voffB);
    PG8_WAIT_V(6); PG8_BAR;
    for (;;) {
        const bool has_next = S.next(ui + 1, nxt);
        const char* nA = has_next ? S.a_base(nxt) : cA; const char* nB = has_next ? S.b_base(nxt) : cB;
        for (int t = 0; t < nt; t += 2) {
            const bool last = (t == nt - 2);
            const char* a1 = cA + (size_t)(t + 1) * kstep;
            const char* a2 = last ? nA : cA + (size_t)(t + 2) * kstep; const char* b2 = last ? nB : cB + (size_t)(t + 2) * kstep;
            const char* a3 = a2 + kstep; const char* b3 = b2 + kstep;
            PG8_LDB(B0, 0, 0); PG8_LDB(B1, 0, 1); PG8_SCHED; PG8_LDA(At, 0, 0); PG8_STAGE(PG8_SA(1, 1), a1 + hstep, voffA);
            PG8_WAIT_V(8); PG8_WAIT_L(0); PG8_BAR; PG8_MMA(0, 0, At, B0); PG8_MMA(0, 1, At, B1); PG8_BAR; PG8_SCHED;
            PG8_LDA(At, 0, 1); PG8_STAGE(PG8_SB(0, 0), b2, voffB); PG8_STAGE(PG8_SB(0, 1), b2 + hstep, voffB); PG8_STAGE(PG8_SA(0, 0), a2, voffA);
            PG8_WAIT_V(8); PG8_WAIT_L(0); PG8_BAR; PG8_MMA(1, 0, At, B0); PG8_MMA(1, 1, At, B1); PG8_BAR; PG8_SCHED;
            PG8_LDB(B0, 1, 0); PG8_LDB(B1, 1, 1); PG8_SCHED; PG8_LDA(At, 1, 0); PG8_STAGE(PG8_SA(0, 1), a2 + hstep, voffA);
            PG8_WAIT_V(8); PG8_WAIT_L(0); PG8_BAR; PG8_MMA(0, 0, At, B0); PG8_MMA(0, 1, At, B1); PG8_BAR; PG8_SCHED;
            PG8_LDA(At, 1, 1); PG8_STAGE(PG8_SB(1, 0), b3, voffB); PG8_STAGE(PG8_SB(1, 1), b3 + hstep, voffB); PG8_STAGE(PG8_SA(1, 0), a3, voffA);
            PG8_WAIT_V(8); PG8_WAIT_L(0); PG8_BAR; PG8_MMA(1, 0, At, B0); PG8_MMA(1, 1, At, B1); PG8_BAR; PG8_SCHED;
        }
        if (wr == 0) PG8_BAR;
        asm volatile("s_nop 15\n\ts_nop 15" ::: "memory");
        E(acc, cur, wr, wc, fr, fq);
        if (!has_next) break;
#pragma unroll
        for (int a = 0; a < 2; ++a)
#pragma unroll
            for (int b = 0; b < 2; ++b)
#pragma unroll
                for (int m = 0; m < 4; ++m)
#pragma unroll
                    for (int n = 0; n < 2; ++n) acc[a][b][m][n] = (f32x4){0.f, 0.f, 0.f, 0.f};
        asm volatile("s_nop 7" ::: "memory");
        cur = nxt; cA = nA; cB = nB; ++ui;
        if (wr == 1) PG8_BAR;
    }
    PG8_WAIT_V(0);
    PG8_BAR;
#undef PG8_SA
#undef PG8_SB
#undef PG8_STAGE
#undef PG8_LD8
#undef PG8_LDA
#undef PG8_LDB
#undef PG8_MMA
#undef PG8_WAIT_V
#undef PG8_WAIT_L
#undef PG8_BAR
#undef PG8_SCHED
}

template <class Epi>
__device__ __forceinline__ void gemm_phase(LAS unsigned char* lds, const Sched& S, const Epi& E) {
    const int tid = threadIdx.x, wid = __builtin_amdgcn_readfirstlane(tid >> 6), lane = tid & 63, wr = wid >> 2, wc = wid & 3, fr = lane & 15, fq = lane >> 4;
    constexpr int nt = K / BK;
    unsigned voffA[2], voffB[2];
#pragma unroll
    for (int i = 0; i < 2; ++i) { int R, C; stage_rc(tid * 16 + i * 8192, R, C); const int Rb = Epi::PERM ? ((R & ~31) + perm32(R & 31)) : R;
        voffA[i] = (unsigned)(R * K + C) * 2u; voffB[i] = (unsigned)(Rb * K + C) * 2u; }
    constexpr size_t kstep = (size_t)(BK * 2);
    constexpr size_t hstep = (size_t)HALF * K * 2;
    const unsigned ldsw = (unsigned)wid * 1024u;
    const int aoff = lds_byte(wr * 64 + fr, fq * 8), boff = lds_byte(wc * 32 + fr, fq * 8);
#define PG8_SA(b, h) (((b) * 2 + (h)) * HTB)
#define PG8_SB(b, h) ((4 + (b) * 2 + (h)) * HTB)
#define PG8_STAGE(bufoff, gbase, voff) do { _Pragma("unroll") for (int _i = 0; _i < 2; ++_i) \
        __builtin_amdgcn_global_load_lds((const unsigned*)((const char*)(gbase) + (voff)[_i]), (LAS unsigned*)(lds + (bufoff) + ldsw + _i * 8192), 16, 0, 0); } while (0)
#define PG8_LDA(dst, b, h) do { _Pragma("unroll") for (int m = 0; m < 4; ++m) _Pragma("unroll") for (int k = 0; k < 2; ++k) dst[m][k] = *(const LAS bf16x8*)(lds + PG8_SA(b, h) + aoff + m * 2048 + k * 1024); } while (0)
#define PG8_LDB(dst, b, h) do { _Pragma("unroll") for (int n = 0; n < 2; ++n) _Pragma("unroll") for (int k = 0; k < 2; ++k) dst[n][k] = *(const LAS bf16x8*)(lds + PG8_SB(b, h) + boff + n * 2048 + k * 1024); } while (0)
#define PG8_MMA(ai, bj, At, Bt) do { __builtin_amdgcn_s_setprio(1); _Pragma("unroll") for (int m = 0; m < 4; ++m) _Pragma("unroll") for (int n = 0; n < 2; ++n) _Pragma("unroll") for (int k = 0; k < 2; ++k) \
        acc[ai][bj][m][n] = __builtin_amdgcn_mfma_f32_16x16x32_bf16(Bt[n][k], At[m][k], acc[ai][bj][m][n], 0, 0, 0); __builtin_amdgcn_s_setprio(0); } while (0)
#define PG8_WAIT_V(n) asm volatile("s_waitcnt vmcnt(" #n ")" ::: "memory")
#define PG8_WAIT_L(n) asm volatile("s_waitcnt lgkmcnt(" #n ")" ::: "memory")
#define PG8_BAR __builtin_amdgcn_s_barrier()
#define PG8_SCHED __builtin_amdgcn_sched_barrier(0)
    Unit cur, nxt; int ui = 0;
    if (!S.next(0, cur)) return;
    f32x4 acc[2][2][4][2];
#pragma unroll
    for (int a = 0; a < 2; ++a)
#pragma unroll
        for (int b = 0; b < 2; ++b)
#pragma unroll
            for (int m = 0; m < 4; ++m)
#pragma unroll
                for (int n = 0; n < 2; ++n) acc[a][b][m][n] = (f32x4){0.f, 0.f, 0.f, 0.f};
    bf16x8 At[4][2], B0[2][2], B1[2][2];
    const char* cA = S.a_base(cur); const char* cB = S.b_base(cur);
    PG8_STAGE(PG8_SB(0, 0), cB, voffB); PG8_STAGE(PG8_SB(0, 1), cB + hstep, voffB); PG8_STAGE(PG8_SA(0, 0), cA, voffA); PG8_STAGE(PG8_SA(0, 1), cA + hstep, voffA);
    if (wr == 1) PG8_BAR;
    PG8_WAIT_V(2); PG8_BAR;
    PG8_STAGE(PG8_SB(1, 0), cB + kstep, voffB); PG8_STAGE(PG8_SA(1, 0), cA + kstep, voffA); PG8_STAGE(PG8_SB(1, 1), cB + hstep + kstep, voffB);
    PG8_WAIT_V(6); PG8_BAR;
    for (;;) {
        const bool has_next = S.next(ui + 1, nxt);
        const char* nA = has_next ? S.a_base(nxt) : cA; const char* nB = has_next ? S.b_base(nxt) : cB;
        for (int t = 0; t < nt; t += 2) {
            const bool last = (t == nt - 2);
            const char* a1 = cA + (size_t)(t + 1) * kstep;
            const char* a2 = last ? nA : cA + (size_t)(t + 2) * kstep; const char* b2 = last ? nB : cB + (size_t)(t + 2) * kstep;
            const char* a3 = a2 + kstep; const char* b3 = b2 + kstep;
            PG8_LDB(B0, 0, 0); PG8_LDB(B1, 0, 1); PG8_SCHED; PG8_LDA(At, 0, 0); PG8_STAGE(PG8_SA(1, 1), a1 + hstep, voffA);
            PG8_WAIT_V(8); PG8_WAIT_L(0); PG8_BAR; PG8_MMA(0, 0, At, B0); PG8_MMA(0, 1, At, B1); PG8_BAR; PG8_SCHED;
            PG8_LDA(At, 0, 1); PG8_STAGE(PG8_SB(0, 0), b2, voffB); PG8_STAGE(PG8_SB(0, 1), b2 + hstep, voffB); PG8_STAGE(PG8_SA(0, 0), a2, voffA);
            PG8_WAIT_V(8); PG8_WAIT_L(0); PG8_BAR; PG8_MMA(1, 0, At, B0); PG8_MMA(1, 1, At, B1); PG8_BAR; PG8_SCHED;
            PG8_LDB(B0, 1, 0); PG8_LDB(B1, 1, 1); PG8_SCHED; PG8_LDA(At, 1, 0); PG8_STAGE(PG8_SA(0, 1), a2 + hstep, voffA);
            PG8_WAIT_V(8); PG8_WAIT_L(0); PG8_BAR; PG8_MMA(0, 0, At, B0); PG8_MMA(0, 1, At, B1); PG8_BAR; PG8_SCHED;
            PG8_LDA(At, 1, 1); PG8_STAGE(PG8_SB(1, 0), b3, voffB); PG8_STAGE(PG8_SB(1, 1), b3 + hstep, voffB); PG8_STAGE(PG8_SA(1, 0), a3, voffA);
            PG8_WAIT_V(8); PG8_WAIT_L(0); PG8_BAR; PG8_MMA(1, 0, At, B0); PG8_MMA(1, 1, At, B1); PG8_BAR; PG8_SCHED;
        }
        if (wr == 0) PG8_BAR;
        E(acc, cur, wr, wc, fr, fq);
        if (!has_next) break;
#pragma unroll
        for (int a = 0; a < 2; ++a)
#pragma unroll
            for (int b = 0; b < 2; ++b)
#pragma unroll
                for (int m = 0; m < 4; ++m)
#pragma unroll
                    for (int n = 0; n < 2; ++n) acc[a][b][m][n] = (f32x4){0.f, 0.f, 0.f, 0.f};
        cur = nxt; cA = nA; cB = nB; ++ui;
        if (wr == 1) PG8_BAR;
    }
    PG8_WAIT_V(0);
    PG8_BAR;
#undef PG8_SA
#undef PG8_SB
#undef PG8_STAGE
#undef PG8_LDA
#undef PG8_LDB
#undef PG8_MMA
#undef PG8_WAIT_V
#undef PG8_WAIT_L
#undef PG8_BAR
#undef PG8_SCHED
}
}

#define MFMA16(a, b, cc) __builtin_amdgcn_mfma_f32_16x16x32_bf16(a, b, cc, 0, 0, 0)
__device__ __forceinline__ bf16x8 pack8(const f32x4 lo, const f32x4 hi) {
    v4u w; w.x = cvt2(lo[0], lo[1]); w.y = cvt2(lo[2], lo[3]); w.z = cvt2(hi[0], hi[1]); w.w = cvt2(hi[2], hi[3]);
    return __builtin_bit_cast(bf16x8, w);
}
__device__ __forceinline__ bf16x8 ld2x8(const LAS bf16* p0, const LAS bf16* p1) {
    const v2u a = *(const LAS v2u*)p0, b = *(const LAS v2u*)p1; v4u w; w.x = a.x; w.y = a.y; w.z = b.x; w.w = b.y; return __builtin_bit_cast(bf16x8, w);
}
#define TP(r) ((((r) & 7) * 17) + ((r) >> 3))
struct GdnLds { LAS float *sb, *sg; LAS bf16 *Qn, *Kn, *Vt, *Kt; LAS float* Lm; LAS bf16* Tm; };
__device__ __forceinline__ void gdn_conv_compute(const Ctx& c, int ug, v4u (&rows)[8], v4u (&cols)[8], float& beta_o, float& g_o) {
    const int n = ug & 63, h = (ug >> 6) & 7, b = ug >> 9, t0 = n * 64; const size_t rowbase = (size_t)b * SEQ;
    const int lane = c.lane, w = c.wave;
    const int cg = c.tid & 15, oct = (c.tid >> 4) & 7, mat = w >> 1;
    const int col = mat * 1024 + h * 128 + 8 * cg;
    v4u rr[11];
#pragma unroll
    for (int i = 0; i < 11; ++i) { const int tt = t0 + 8 * oct - 3 + i; const v4u ld = *(const v4u*)(c.PROJ + (rowbase + (tt < 0 ? 0 : tt)) * NPROJ + col); const unsigned msk = tt < 0 ? 0u : 0xffffffffu; rr[i] = (v4u){ld.x & msk, ld.y & msk, ld.z & msk, ld.w & msk}; }
    f32x4 cw[4][2];
#pragma unroll
    for (int i = 0; i < 4; ++i) { cw[i][0] = *(const f32x4*)(c.conv_w + i * 3072 + col); cw[i][1] = *(const f32x4*)(c.conv_w + i * 3072 + col + 4); }
    if (w == 0) {
        const size_t row = rowbase + t0 + lane;
        beta_o = sigmoidf_(c.ba[row * 16 + h]);
        float gs = -expf(c.a_log[h]) * softplusf_(c.ba[row * 16 + 8 + h] + c.dt_bias[h]);
#pragma unroll
        for (int o = 1; o < 64; o <<= 1) { const float t = __shfl_up(gs, o); if (lane >= o) gs += t; }
        g_o = gs;
    }
#pragma unroll
    for (int tp = 0; tp < 4; ++tp) {
        float y[2][8];
#pragma unroll
        for (int hh = 0; hh < 2; ++hh) { const int tk = 2 * tp + hh;
#pragma unroll
            for (int e = 0; e < 8; ++e) y[hh][e] = 0.f;
#pragma unroll
            for (int i = 0; i < 4; ++i) { const v4u ru = rr[tk + i]; const f32x4 u0 = {bflo(ru.x), bfhi(ru.x), bflo(ru.y), bfhi(ru.y)}, u1 = {bflo(ru.z), bfhi(ru.z), bflo(ru.w), bfhi(ru.w)};
                y[hh][0] += cw[i][0].x * u0.x; y[hh][1] += cw[i][0].y * u0.y; y[hh][2] += cw[i][0].z * u0.z; y[hh][3] += cw[i][0].w * u0.w;
                y[hh][4] += cw[i][1].x * u1.x; y[hh][5] += cw[i][1].y * u1.y; y[hh][6] += cw[i][1].z * u1.z; y[hh][7] += cw[i][1].w * u1.w; }
#pragma unroll
            for (int e = 0; e < 8; ++e) y[hh][e] = siluf(y[hh][e]);
            if (mat < 2) {
                float ss = 0.f;
#pragma unroll
                for (int e = 0; e < 8; ++e) ss += y[hh][e] * y[hh][e];
                ss += __shfl_xor(ss, 1); ss += __shfl_xor(ss, 2); ss += __shfl_xor(ss, 4); ss += __shfl_xor(ss, 8);
                const float rs = rsqrtf(ss + EPS) * (mat == 0 ? 0.08838834764831845f : 1.f);
#pragma unroll
                for (int e = 0; e < 8; ++e) y[hh][e] *= rs;
                v4u pw; pw.x = pk2(y[hh][0], y[hh][1]); pw.y = pk2(y[hh][2], y[hh][3]); pw.z = pk2(y[hh][4], y[hh][5]); pw.w = pk2(y[hh][6], y[hh][7]);
                rows[tk] = pw;
            }
        }
        if (mat >= 1) {
#pragma unroll
            for (int e = 0; e < 8; ++e) { const unsigned wd = pk2(y[0][e], y[1][e]); if (tp == 0) cols[e].x = wd; else if (tp == 1) cols[e].y = wd; else if (tp == 2) cols[e].z = wd; else cols[e].w = wd; } }
    }
}
__device__ __forceinline__ void gdn_conv_write(const Ctx& c, int ug, const GdnLds& P, const v4u (&rows)[8], const v4u (&cols)[8], float beta, float g) {
    const int w = c.wave, cg = c.tid & 15, oct = (c.tid >> 4) & 7, mat = w >> 1;
    if (mat < 2) {
#pragma unroll
        for (int tk = 0; tk < 8; ++tk) *(LAS v4u*)((mat == 0 ? P.Qn : P.Kn) + (8 * oct + tk) * 136 + 8 * cg) = rows[tk]; }
    if (mat >= 1) { LAS bf16* dt = (mat == 1 ? P.Kt : P.Vt);
#pragma unroll
        for (int e = 0; e < 8; ++e) *(LAS v4u*)(dt + TP(8 * cg + e) * 72 + 8 * oct) = cols[e]; }
    if (w == 0) { P.sb[c.lane] = beta; P.sg[c.lane] = g; if (c.lane == 63) c.gcd[ug] = expf(g); }
}
__device__ __forceinline__ void gdn_step2(const Ctx& c, int ug, const GdnLds& P) {
    const int lane = c.lane, q = lane >> 4, r = lane & 15, w = c.wave;
    unsigned char* img = c.gimg + (size_t)ug * GIMG_BYTES;
    LAS bf16* Qn = P.Qn; LAS bf16* Kn = P.Kn; LAS float* sb = P.sb; LAS float* sg = P.sg; LAS float* Lm = P.Lm;
#pragma unroll
    for (int tt = 0; tt < 2; ++tt) { const int tile = 2 * w + tt, ib = tile >> 2, jb = tile & 3;
        f32x4 acc = {0.f, 0.f, 0.f, 0.f};
#pragma unroll
        for (int s = 0; s < 4; ++s) { const bf16x8 a = *(const LAS bf16x8*)(Kn + (16 * ib + r) * 136 + 32 * s + 8 * q), bb = *(const LAS bf16x8*)(Kn + (16 * jb + r) * 136 + 32 * s + 8 * q); acc = MFMA16(a, bb, acc); }
        const int j = 16 * jb + r; const float gj = sg[j];
#pragma unroll
        for (int d = 0; d < 4; ++d) { const int i = 16 * ib + 4 * q + d; Lm[i * 68 + j] = (j < i) ? sb[i] * acc[d] * __expf(sg[i] - gj) : 0.f; } }
    { const int ib = w >> 1, s2 = w & 1;
        f32x4 a0 = {0.f, 0.f, 0.f, 0.f}, a1 = {0.f, 0.f, 0.f, 0.f};
#pragma unroll
        for (int s = 0; s < 4; ++s) { const bf16x8 bq = *(const LAS bf16x8*)(Qn + (16 * ib + r) * 136 + 32 * s + 8 * q);
            const bf16x8 k0 = *(const LAS bf16x8*)(Kn + (32 * s2 + r) * 136 + 32 * s + 8 * q), k1 = *(const LAS bf16x8*)(Kn + (32 * s2 + 16 + r) * 136 + 32 * s + 8 * q);
            a0 = MFMA16(k0, bq, a0); a1 = MFMA16(k1, bq, a1); }
        const int i = 16 * ib + r; const float gi = sg[i]; f32x4 o0, o1;
#pragma unroll
        for (int d = 0; d < 4; ++d) { const int j0 = 32 * s2 + 4 * q + d, j1 = j0 + 16;
            o0[d] = (j0 <= i) ? a0[d] * __expf(gi - sg[j0]) : 0.f; o1[d] = (j1 <= i) ? a1[d] * __expf(gi - sg[j1]) : 0.f; }
        *(bf16x8*)(img + 32768 + ((ib * 2 + s2) * 64 + lane) * 16) = pack8(o0, o1); }
}
__device__ __forceinline__ void gdn_solve(const Ctx& c, const GdnLds& P, int copy) {
    const int lane = c.lane;
    float Tc[64];
    int zoff = 0; asm volatile("v_mov_b32 %0, 0" : "=v"(zoff));
    const LAS float* Lz = P.Lm + zoff;
    const float scl = P.sb[lane] * (copy == 0 ? 1.f : expf(P.sg[lane]));
#define LROW(dst, row, half, nv) do { _Pragma("unroll") for (int _k = 0; _k < (nv); ++_k) dst[_k] = *(const LAS f32x4*)(Lz + (row) * 68 + 32 * (half) + 4 * _k); } while (0)
    f32x4 X[8], Y[8];
    Tc[0] = (lane == 0) ? scl : 0.f;
    LROW(Y, 1, 0, 1);
#pragma unroll
    for (int i = 1; i < 32; ++i) {
        if (i & 1) LROW(X, i + 1, 0, (i + 4) / 4 > 8 ? 8 : (i + 4) / 4); else LROW(Y, i + 1, 0, (i + 4) / 4 > 8 ? 8 : (i + 4) / 4);
        __builtin_amdgcn_sched_barrier(0);
        float a0 = (i == lane) ? scl : 0.f, a1 = 0.f, a2 = 0.f, a3 = 0.f;
#pragma unroll
        for (int m = 0; m < i; ++m) { const float lv = ((i & 1) ? Y[m >> 2][m & 3] : X[m >> 2][m & 3]);
            if ((m & 3) == 0) a0 -= lv * Tc[m]; else if ((m & 3) == 1) a1 -= lv * Tc[m]; else if ((m & 3) == 2) a2 -= lv * Tc[m]; else a3 -= lv * Tc[m]; }
        Tc[i] = (a0 + a1) + (a2 + a3);
        __builtin_amdgcn_sched_barrier(0);
    }
#pragma unroll
    for (int i = 32; i < 64; ++i) {
        if (i > 32) LROW(Y, i, 1, (i - 32 + 3) / 4);
        __builtin_amdgcn_sched_barrier(0);
        float a0 = (i == lane) ? scl : 0.f, a1 = 0.f, a2 = 0.f, a3 = 0.f;
#pragma unroll
        for (int m = 0; m < 32; ++m) { const float lv = X[m >> 2][m & 3];
            if ((m & 3) == 0) a0 -= lv * Tc[m]; else if ((m & 3) == 1) a1 -= lv * Tc[m]; else if ((m & 3) == 2) a2 -= lv * Tc[m]; else a3 -= lv * Tc[m]; }
        __builtin_amdgcn_sched_barrier(0);
        if (i + 1 < 64) LROW(X, i + 1, 0, 8);
        __builtin_amdgcn_sched_barrier(0);
#pragma unroll
        for (int m = 32; m < i; ++m) { const float lv = Y[(m - 32) >> 2][m & 3];
            if ((m & 3) == 0) a0 -= lv * Tc[m]; else if ((m & 3) == 1) a1 -= lv * Tc[m]; else if ((m & 3) == 2) a2 -= lv * Tc[m]; else a3 -= lv * Tc[m]; }
        Tc[i] = (a0 + a1) + (a2 + a3);
        __builtin_amdgcn_sched_barrier(0);
    }
#undef LROW
    LAS bf16* Td = P.Tm + copy * 4608;
#pragma unroll
    for (int i = 0; i < 64; ++i) Td[i * 72 + lane] = (bf16)f2bf(Tc[i]);
}
__device__ __forceinline__ void gdn_exports(const Ctx& c, int ug, const GdnLds& P, int w6) {
    const int lane = c.lane, q = lane >> 4, r = lane & 15;
    unsigned char* img = c.gimg + (size_t)ug * GIMG_BYTES;
    LAS bf16* Qn = P.Qn; LAS bf16* Kn = P.Kn; LAS float* sg = P.sg;
    const float glast = sg[63];
    for (int f = w6; f < 32; f += 6) {
        if (f < 16) { const int mb = f >> 2, s = f & 3, i = 16 * mb + r; const LAS bf16* p = Qn + i * 136 + 32 * s + 4 * q;
            const v2u lo = *(const LAS v2u*)p, hi = *(const LAS v2u*)(p + 16); const float eg = __expf(sg[i]);
            const f32x4 a = {bflo(lo.x) * eg, bfhi(lo.x) * eg, bflo(lo.y) * eg, bfhi(lo.y) * eg}, bb = {bflo(hi.x) * eg, bfhi(hi.x) * eg, bflo(hi.y) * eg, bfhi(hi.y) * eg};
            *(bf16x8*)(img + 16384 + ((mb * 4 + s) * 64 + lane) * 16) = pack8(a, bb);
        } else { const int ff = f - 16, db = ff >> 1, s2 = ff & 1, dk = 16 * db + r; f32x4 a, bb;
#pragma unroll
            for (int e = 0; e < 4; ++e) { const int j0 = 32 * s2 + 4 * q + e, j1 = j0 + 16;
                a[e] = bf2f(Kn[j0 * 136 + dk]) * __expf(glast - sg[j0]); bb[e] = bf2f(Kn[j1 * 136 + dk]) * __expf(glast - sg[j1]); }
            *(bf16x8*)(img + 40960 + ((db * 2 + s2) * 64 + lane) * 16) = pack8(a, bb); }
    }
}
__device__ __forceinline__ void gdn_step4(const Ctx& c, int ug, const GdnLds& P) {
    const int lane = c.lane, q = lane >> 4, r = lane & 15, w = c.wave;
    unsigned char* img = c.gimg + (size_t)ug * GIMG_BYTES; float* uimg = c.gu + (size_t)ug * 8192;
    LAS bf16* Tm = P.Tm; LAS bf16* Vt = P.Vt; LAS bf16* Kt = P.Kt;
#pragma unroll
    for (int mb = 0; mb < 4; ++mb) { f32x4 acc = {0.f, 0.f, 0.f, 0.f};
#pragma unroll
        for (int s2 = 0; s2 < 2; ++s2) { const bf16x8 a = *(const LAS bf16x8*)(Tm + (16 * mb + r) * 72 + 32 * s2 + 8 * q), bb = *(const LAS bf16x8*)(Vt + TP(16 * w + r) * 72 + 32 * s2 + 8 * q); acc = MFMA16(a, bb, acc); }
        { v2u pw; pw.x = cvt2(acc[0], acc[1]); pw.y = cvt2(acc[2], acc[3]); *(v2u*)((bf16*)uimg + ((w * 4 + mb) * 64 + lane) * 4) = pw; } }
#pragma unroll
    for (int ff = 0; ff < 2; ++ff) { const int f = 2 * w + ff, mb = f >> 2, s = f & 3;
        f32x4 a0 = {0.f, 0.f, 0.f, 0.f}, a1 = {0.f, 0.f, 0.f, 0.f};
#pragma unroll
        for (int s2 = 0; s2 < 2; ++s2) { const bf16x8 bt = *(const LAS bf16x8*)(Tm + 4608 + (16 * mb + r) * 72 + 32 * s2 + 8 * q);
            const bf16x8 k0 = *(const LAS bf16x8*)(Kt + TP(32 * s + r) * 72 + 32 * s2 + 8 * q), k1 = *(const LAS bf16x8*)(Kt + TP(32 * s + 16 + r) * 72 + 32 * s2 + 8 * q);
            a0 = MFMA16(k0, bt, a0); a1 = MFMA16(k1, bt, a1); }
        *(bf16x8*)(img + ((mb * 4 + s) * 64 + lane) * 16) = pack8(-a0, -a1); }
}
__device__ __forceinline__ void prep_gdn_all(const Ctx& c) {
    GdnLds P;
    P.sb = (LAS float*)c.lds; P.sg = P.sb + 64;
    P.Qn = (LAS bf16*)(c.lds + 1024);
    P.Kn = (LAS bf16*)(c.lds + 18432);
    P.Vt = (LAS bf16*)(c.lds + 35840);
    P.Kt = (LAS bf16*)(c.lds + 55296);
    P.Lm = (LAS float*)(c.lds + 74752);
    P.Tm = (LAS bf16*)(c.lds + 92160);
    const int w = c.wave;
    v4u rows[8], cols[8]; float beta = 0.f, g = 0.f;
#pragma unroll
    for (int i = 0; i < 8; ++i) { rows[i] = (v4u){0u, 0u, 0u, 0u}; cols[i] = (v4u){0u, 0u, 0u, 0u}; }
    int ug = c.bid;
    if (ug < 2048 && w < 6) gdn_conv_compute(c, ug, rows, cols, beta, g);
    for (; ug < 2048; ug += c.G) {
        if (w < 6) gdn_conv_write(c, ug, P, rows, cols, beta, g);
        __syncthreads();
        gdn_step2(c, ug, P);
        __syncthreads();
        if (w >= 6) { gdn_solve(c, P, w - 6);
#pragma unroll
            for (int i = 0; i < 8; ++i) { rows[i] = (v4u){0u, 0u, 0u, 0u}; cols[i] = (v4u){0u, 0u, 0u, 0u}; } }
        else { gdn_exports(c, ug, P, w); if (ug + c.G < 2048) gdn_conv_compute(c, ug + c.G, rows, cols, beta, g); }
        __syncthreads();
        gdn_step4(c, ug, P);
        __syncthreads();
    }
}
#undef TP
__device__ __forceinline__ void prep_ret(const Ctx& c, int ur) {
    const int n = ur & 63, h = (ur >> 6) & 3, b = ur >> 8, t0 = n * 64;
    const size_t rowbase = (size_t)b * SEQ + t0;
    const int lane = c.lane, q = lane >> 4, r = lane & 15, w = c.wave;
    LAS bf16* Qr = (LAS bf16*)c.lds;
    LAS bf16* Kr = (LAS bf16*)(c.lds + 33792);
    LAS bf16* Vt = (LAS bf16*)(c.lds + 67584);
    unsigned char* img = c.rimg + (size_t)ur * RIMG_BYTES; float* inner = c.rinner + (size_t)ur * 16384; unsigned char* vf = c.rvf + (size_t)ur * 32768;
    const float lg2 = log2f(1.f - exp2f(-5.f - (float)h));
    {
        v4u qa[2], qb[2], ka[2], kb[2]; f32x4 cs[2][4];
#pragma unroll
        for (int it = 0; it < 2; ++it) { const int item = it * NTHREADS + c.tid, tok = item >> 4, i0 = (item & 15) * 8; const size_t row = rowbase + tok;
            const bf16* pr = c.PROJ + row * NPROJ + 4096 + h * 256 + i0;
            qa[it] = *(const v4u*)pr; qb[it] = *(const v4u*)(pr + 128); ka[it] = *(const v4u*)(pr + 1024); kb[it] = *(const v4u*)(pr + 1024 + 128);
            const f32x4* rp = (const f32x4*)(c.rot + row * 128 + i0);
#pragma unroll
            for (int p = 0; p < 4; ++p) cs[it][p] = rp[p]; }
#pragma unroll
        for (int it = 0; it < 2; ++it) { const int item = it * NTHREADS + c.tid, tok = item >> 4, i0 = (item & 15) * 8;
            const unsigned qaw[4] = {qa[it].x, qa[it].y, qa[it].z, qa[it].w}, qbw[4] = {qb[it].x, qb[it].y, qb[it].z, qb[it].w}, kaw[4] = {ka[it].x, ka[it].y, ka[it].z, ka[it].w}, kbw[4] = {kb[it].x, kb[it].y, kb[it].z, kb[it].w};
            unsigned oq1[4], oq2[4], ok1[4], ok2[4];
#pragma unroll
            for (int p = 0; p < 4; ++p) { float r1[2], r2[2], r3[2], r4[2];
#pragma unroll
                for (int hh = 0; hh < 2; ++hh) { const float cc = hh ? cs[it][p].z : cs[it][p].x, sn = hh ? cs[it][p].w : cs[it][p].y;
                    const float x1 = hh ? bfhi(qaw[p]) : bflo(qaw[p]), x2 = hh ? bfhi(qbw[p]) : bflo(qbw[p]), y1 = hh ? bfhi(kaw[p]) : bflo(kaw[p]), y2 = hh ? bfhi(kbw[p]) : bflo(kbw[p]);
                    r1[hh] = x1 * cc - x2 * sn; r2[hh] = x2 * cc + x1 * sn; r3[hh] = (y1 * cc - y2 * sn) * 0.0625f; r4[hh] = (y2 * cc + y1 * sn) * 0.0625f; }
                oq1[p] = pk2(r1[0], r1[1]); oq2[p] = pk2(r2[0], r2[1]); ok1[p] = pk2(r3[0], r3[1]); ok2[p] = pk2(r4[0], r4[1]); }
            v4u t;
            t.x = oq1[0]; t.y = oq1[1]; t.z = oq1[2]; t.w = oq1[3]; *(LAS v4u*)(Qr + tok * 264 + i0) = t;
            t.x = oq2[0]; t.y = oq2[1]; t.z = oq2[2]; t.w = oq2[3]; *(LAS v4u*)(Qr + tok * 264 + 128 + i0) = t;
            t.x = ok1[0]; t.y = ok1[1]; t.z = ok1[2]; t.w = ok1[3]; *(LAS v4u*)(Kr + tok * 264 + i0) = t;
            t.x = ok2[0]; t.y = ok2[1]; t.z = ok2[2]; t.w = ok2[3]; *(LAS v4u*)(Kr + tok * 264 + 128 + i0) = t; }
    }
    { v4u vv[4];
#pragma unroll
        for (int it = 0; it < 4; ++it) { const int item = it * NTHREADS + c.tid, tok = item & 63, vg = item >> 6; vv[it] = *(const v4u*)(c.PROJ + (rowbase + tok) * NPROJ + 6144 + h * 256 + 8 * vg); }
#pragma unroll
        for (int it = 0; it < 4; ++it) { const int item = it * NTHREADS + c.tid, tok = item & 63, vg = item >> 6; const v4u u = vv[it];
            LAS bf16* d = Vt + (8 * vg) * 72 + tok;
            d[0] = (bf16)(u.x & 0xffff); d[72] = (bf16)(u.x >> 16); d[144] = (bf16)(u.y & 0xffff); d[216] = (bf16)(u.y >> 16);
            d[288] = (bf16)(u.z & 0xffff); d[360] = (bf16)(u.z >> 16); d[432] = (bf16)(u.w & 0xffff); d[504] = (bf16)(u.w >> 16); } }
    __syncthreads();
    {
        const int ib = w >> 1, half = w & 1, i = 16 * ib + r;
        bf16x8 scf[2];
#pragma unroll
        for (int s2 = 0; s2 < 2; ++s2) { f32x4 a0 = {0.f, 0.f, 0.f, 0.f}, a1 = {0.f, 0.f, 0.f, 0.f};
#pragma unroll
            for (int s = 0; s < 8; ++s) { const bf16x8 bq = *(const LAS bf16x8*)(Qr + i * 264 + 32 * s + 8 * q);
                const bf16x8 k0 = *(const LAS bf16x8*)(Kr + (32 * s2 + r) * 264 + 32 * s + 8 * q), k1 = *(const LAS bf16x8*)(Kr + (32 * s2 + 16 + r) * 264 + 32 * s + 8 * q);
                a0 = MFMA16(k0, bq, a0); a1 = MFMA16(k1, bq, a1); }
            f32x4 o0, o1;
#pragma unroll
            for (int d = 0; d < 4; ++d) { const int j0 = 32 * s2 + 4 * q + d, j1 = j0 + 16;
                o0[d] = (j0 <= i) ? a0[d] * exp2f((float)(i - j0) * lg2) : 0.f; o1[d] = (j1 <= i) ? a1[d] * exp2f((float)(i - j1) * lg2) : 0.f; }
            scf[s2] = pack8(o0, o1); }
#pragma unroll
        for (int x = 0; x < 8; ++x) { const int nb = 8 * half + x; f32x4 acc = {0.f, 0.f, 0.f, 0.f};
#pragma unroll
            for (int s2 = 0; s2 < 2; ++s2) { const LAS bf16* p = Vt + (16 * nb + r) * 72 + 32 * s2 + 4 * q; acc = MFMA16(scf[s2], ld2x8(p, p + 16), acc); }
            { v2u pw; pw.x = cvt2(acc[0], acc[1]); pw.y = cvt2(acc[2], acc[3]); *(v2u*)((bf16*)inner + ((nb * 4 + ib) * 64 + lane) * 4) = pw; } }
    }
#pragma unroll
    for (int x = 0; x < 4; ++x) { const int nb = 2 * w + (x >> 1), s2 = x & 1; const LAS bf16* p = Vt + (16 * nb + r) * 72 + 32 * s2 + 4 * q;
        *(bf16x8*)(vf + ((nb * 2 + s2) * 64 + lane) * 16) = ld2x8(p, p + 16); }
#pragma unroll 1
    for (int f = w; f < 32; f += 8) { const int mb = f >> 3, s = f & 7, i = 16 * mb + r; const LAS bf16* p = Qr + i * 264 + 32 * s + 4 * q;
        const v2u lo = *(const LAS v2u*)p, hi = *(const LAS v2u*)(p + 16); const float eg = exp2f((float)(i + 1) * lg2);
        const f32x4 a = {bflo(lo.x) * eg, bfhi(lo.x) * eg, bflo(lo.y) * eg, bfhi(lo.y) * eg}, bb = {bflo(hi.x) * eg, bfhi(hi.x) * eg, bflo(hi.y) * eg, bfhi(hi.y) * eg};
        *(bf16x8*)(img + ((mb * 8 + s) * 64 + lane) * 16) = pack8(a, bb); }
#pragma unroll 1
    for (int f = w; f < 32; f += 8) { const int db = f >> 1, s2 = f & 1, dk = 16 * db + r; f32x4 a, bb;
#pragma unroll
        for (int e = 0; e < 4; ++e) { const int j0 = 32 * s2 + 4 * q + e, j1 = j0 + 16;
            a[e] = bf2f(Kr[j0 * 264 + dk]) * exp2f((float)(63 - j0) * lg2); bb[e] = bf2f(Kr[j1 * 264 + dk]) * exp2f((float)(63 - j1) * lg2); }
        *(bf16x8*)(img + 32768 + ((db * 2 + s2) * 64 + lane) * 16) = pack8(a, bb); }
    __syncthreads();
}
__device__ __forceinline__ void stage_image(LAS unsigned char* dst, const unsigned char* src, int npieces, int tid, int wave) {
    for (int k = 0; k < npieces; ++k)
        __builtin_amdgcn_global_load_lds((const unsigned*)(src + k * 8192 + tid * 16), (LAS unsigned*)(dst + k * 8192 + wave * 1024), 16, 0, 0);
}
__device__ __forceinline__ f32x4 gload16(const void* p) { return *(const f32x4*)p; }
__device__ __forceinline__ f32x4 gload8bf(const void* p) { const v2u w = *(const v2u*)p; return (f32x4){bflo(w.x), bfhi(w.x), bflo(w.y), bfhi(w.y)}; }
#define SCAN_WAIT4(n, a, b, cc, d) asm volatile("s_waitcnt vmcnt(" #n ")" : "+v"(a), "+v"(b), "+v"(cc), "+v"(d) :: "memory")
#define SCAN_WAIT2(n, a, b) asm volatile("s_waitcnt vmcnt(" #n ")" : "+v"(a), "+v"(b) :: "memory")
#define LDF(off) (*(const LAS bf16x8*)(buf + (off) + lane * 16))
#define SB() __builtin_amdgcn_sched_barrier(0)
__device__ __forceinline__ void scan_gdn(const Ctx& c, int u) {
    const int bh = u, b = bh >> 3, h = bh & 7, w = c.wave, lane = c.lane, q = lane >> 4, r = lane & 15;
    const bool active = true; const int dvb = w;
    const unsigned char* img0 = c.gimg + (size_t)bh * 64 * GIMG_BYTES;
    const bf16* u0 = (const bf16*)c.gu + (size_t)bh * 64 * 16384 + (dvb * 4) * 256 + lane * 4;
    bf16* obase = c.Ob + ((size_t)b * SEQ + 4 * q) * D + h * 128 + 16 * dvb + r;
    LAS float* cdl = (LAS float*)(c.lds + 2 * GIMG_BYTES);
    if (c.tid < 64) cdl[c.tid] = c.gcd[bh * 64 + c.tid];
    f32x4 S[8];
#pragma unroll
    for (int i = 0; i < 8; ++i) S[i] = (f32x4){0.f, 0.f, 0.f, 0.f};
    f32x4 U0, U1, U2, U3, N0, N1, N2, N3;
    stage_image(c.lds, img0, 7, c.tid, w);
    U0 = gload8bf(u0); U1 = gload8bf(u0 + 256); U2 = gload8bf(u0 + 512); U3 = gload8bf(u0 + 768);
    SCAN_WAIT4(0, U0, U1, U2, U3); N0 = U0; N1 = U1; N2 = U2; N3 = U3;
    __syncthreads();
#pragma unroll 1
    for (int n = 0; n < 64; ++n) {
        const LAS unsigned char* buf = c.lds + (n & 1) * GIMG_BYTES;
        if (n + 1 < 64) { stage_image(c.lds + ((n + 1) & 1) * GIMG_BYTES, img0 + (size_t)(n + 1) * GIMG_BYTES, 7, c.tid, w);
            const bf16* un = u0 + (size_t)(n + 1) * 16384; N0 = gload8bf(un); N1 = gload8bf(un + 256); N2 = gload8bf(un + 512); N3 = gload8bf(un + 768); }
        if (active) {
            const float cd = cdl[n];
            bf16x8 Sf[4];
#pragma unroll
            for (int s = 0; s < 4; ++s) Sf[s] = pack8(S[2 * s], S[2 * s + 1]);
            f32x4 D1[4]; D1[0] = U0; D1[1] = U1; D1[2] = U2; D1[3] = U3;
            f32x4 Oa[4];
            bf16x8 Df[2];
            bf16x8 fa[4], fb[4];
#pragma unroll
            for (int f = 0; f < 4; ++f) fa[f] = LDF(f * 1024);
            SB();
#pragma unroll
            for (int bt = 0; bt < 14; ++bt) {
                if (bt + 1 < 14) {
#pragma unroll
                    for (int f = 0; f < 4; ++f) { if (bt & 1) fa[f] = LDF(((bt + 1) * 4 + f) * 1024); else fb[f] = LDF(((bt + 1) * 4 + f) * 1024); }
                }
                SB();
                if (bt < 4) {
#pragma unroll
                    for (int f = 0; f < 4; ++f) D1[bt] = MFMA16((bt & 1) ? fb[f] : fa[f], Sf[f], D1[bt]);
                    if (bt == 3) { Df[0] = pack8(D1[0], D1[1]); Df[1] = pack8(D1[2], D1[3]); }
                } else if (bt < 8) {
                    f32x4 acc = {0.f, 0.f, 0.f, 0.f};
#pragma unroll
                    for (int f = 0; f < 4; ++f) acc = MFMA16((bt & 1) ? fb[f] : fa[f], Sf[f], acc);
                    Oa[bt - 4] = acc;
                } else if (bt < 10) {
#pragma unroll
                    for (int x = 0; x < 2; ++x) { const int mb = 2 * (bt - 8) + x; f32x4 acc = Oa[mb];
                        acc = MFMA16((bt & 1) ? fb[2 * x] : fa[2 * x], Df[0], acc); acc = MFMA16((bt & 1) ? fb[2 * x + 1] : fa[2 * x + 1], Df[1], acc);
                        bf16* op = obase + (size_t)(n * 64 + 16 * mb) * D;
                        op[0] = (bf16)f2bf(acc[0]); op[D] = (bf16)f2bf(acc[1]); op[2 * D] = (bf16)f2bf(acc[2]); op[3 * D] = (bf16)f2bf(acc[3]); }
                } else {
#pragma unroll
                    for (int x = 0; x < 2; ++x) { const int db = 2 * (bt - 10) + x; f32x4 acc = S[db] * cd;
                        acc = MFMA16((bt & 1) ? fb[2 * x] : fa[2 * x], Df[0], acc); acc = MFMA16((bt & 1) ? fb[2 * x + 1] : fa[2 * x + 1], Df[1], acc); S[db] = acc; }
                }
                SB();
            }
        }
        if (active) SCAN_WAIT4(16, N0, N1, N2, N3); else SCAN_WAIT4(0, N0, N1, N2, N3);
        U0 = N0; U1 = N1; U2 = N2; U3 = N3;
        LDS_WAIT(); __builtin_amdgcn_s_barrier(); asm volatile("" ::: "memory");
    }
}
__device__ __forceinline__ void scan_ret(const Ctx& c, int u) {
    const int qt = u & 1, bh = u >> 1, b = bh >> 2, h = bh & 3, w = c.wave, lane = c.lane, q = lane >> 4, r = lane & 15;
    const bool active = true; const int nb = 8 * qt + w;
    const unsigned char* img0 = c.rimg + (size_t)bh * 64 * RIMG_BYTES;
    const bf16* in0 = (const bf16*)c.rinner + (size_t)bh * 64 * 32768 + (nb * 4) * 256 + lane * 4;
    const unsigned char* vf0 = c.rvf + (size_t)bh * 64 * 32768 + ((nb * 2) * 64 + lane) * 16;
    bf16* obase = c.Ob + ((size_t)b * SEQ + 4 * q) * D + 1024 + h * 256 + 16 * nb + r;
    const float cd = exp2f(64.f * log2f(1.f - exp2f(-5.f - (float)h)));
    f32x4 S[16];
#pragma unroll
    for (int i = 0; i < 16; ++i) S[i] = (f32x4){0.f, 0.f, 0.f, 0.f};
    f32x4 I0, I1, I2, I3, N0, N1, N2, N3, V0, V1, W0, W1;
    stage_image(c.lds, img0, 8, c.tid, w);
    I0 = gload8bf(in0); I1 = gload8bf(in0 + 256); I2 = gload8bf(in0 + 512); I3 = gload8bf(in0 + 768); V0 = gload16(vf0); V1 = gload16(vf0 + 1024);
    SCAN_WAIT4(0, I0, I1, I2, I3); SCAN_WAIT2(0, V0, V1); N0 = I0; N1 = I1; N2 = I2; N3 = I3; W0 = V0; W1 = V1;
    __syncthreads();
#pragma unroll 1
    for (int n = 0; n < 64; ++n) {
        const LAS unsigned char* buf = c.lds + (n & 1) * RIMG_BYTES;
        if (n + 1 < 64) { stage_image(c.lds + ((n + 1) & 1) * RIMG_BYTES, img0 + (size_t)(n + 1) * RIMG_BYTES, 8, c.tid, w);
            const bf16* inn = in0 + (size_t)(n + 1) * 32768; const unsigned char* vn = vf0 + (size_t)(n + 1) * 32768;
            N0 = gload8bf(inn); N1 = gload8bf(inn + 256); N2 = gload8bf(inn + 512); N3 = gload8bf(inn + 768); W0 = gload16(vn); W1 = gload16(vn + 1024); }
        if (active) {
            bf16x8 Sf[8];
#pragma unroll
            for (int s = 0; s < 8; ++s) Sf[s] = pack8(S[2 * s], S[2 * s + 1]);
            const bf16x8 Vf0 = __builtin_bit_cast(bf16x8, V0), Vf1 = __builtin_bit_cast(bf16x8, V1);
            f32x4 Oa[4]; Oa[0] = I0; Oa[1] = I1; Oa[2] = I2; Oa[3] = I3;
            bf16x8 fa[4], fb[4];
#pragma unroll
            for (int f = 0; f < 4; ++f) fa[f] = LDF(f * 1024);
            SB();
#pragma unroll
            for (int bt = 0; bt < 16; ++bt) {
                if (bt + 1 < 16) {
#pragma unroll
                    for (int f = 0; f < 4; ++f) { if (bt & 1) fa[f] = LDF(((bt + 1) * 4 + f) * 1024); else fb[f] = LDF(((bt + 1) * 4 + f) * 1024); }
                }
                SB();
                if (bt < 8) { const int mb = bt >> 1; f32x4 acc = Oa[mb];
#pragma unroll
                    for (int f = 0; f < 4; ++f) acc = MFMA16((bt & 1) ? fb[f] : fa[f], Sf[4 * (bt & 1) + f], acc);
                    Oa[mb] = acc;
                    if (bt & 1) { bf16* op = obase + (size_t)(n * 64 + 16 * mb) * D; op[0] = (bf16)f2bf(acc[0]); op[D] = (bf16)f2bf(acc[1]); op[2 * D] = (bf16)f2bf(acc[2]); op[3 * D] = (bf16)f2bf(acc[3]); }
                } else {
#pragma unroll
                    for (int x = 0; x < 2; ++x) { const int db = 2 * (bt - 8) + x; f32x4 acc = S[db] * cd;
                        acc = MFMA16((bt & 1) ? fb[2 * x] : fa[2 * x], Vf0, acc); acc = MFMA16((bt & 1) ? fb[2 * x + 1] : fa[2 * x + 1], Vf1, acc); S[db] = acc; }
                }
                SB();
            }
        }
        if (active) { SCAN_WAIT4(16, N0, N1, N2, N3); SCAN_WAIT2(16, W0, W1); } else { SCAN_WAIT4(0, N0, N1, N2, N3); SCAN_WAIT2(0, W0, W1); }
        I0 = N0; I1 = N1; I2 = N2; I3 = N3; V0 = W0; V1 = W1;
        LDS_WAIT(); __builtin_amdgcn_s_barrier(); asm volatile("" ::: "memory");
    }
}
#undef LDF
#undef SB
__device__ __forceinline__ void ph_mixer_prep(const Ctx& c) {
    prep_gdn_all(c);
    for (int u = c.bid; u < 1024; u += c.G) prep_ret(c, u);
}
__device__ __forceinline__ void ph_mixer_scan(const Ctx& c) {
    for (int u = c.bid; u < SCAN_UNITS; u += c.G) { if (u < 32) scan_gdn(c, u); else { const int v = u - 32, xcd = v & 7, grp = v >> 3; scan_ret(c, (xcd + 8 * (grp >> 1)) * 2 + (grp & 1)); } __syncthreads(); }
    if (c.G > SCAN_UNITS) {
        unsigned* qw = (unsigned*)c.ctl + CW_CONVQ;
        LAS unsigned* slot = (LAS unsigned*)(c.lds + 8 * 8704);
        LAS float* scr = (LAS float*)(c.lds + c.wave * 8704);
        for (;;) {
            __syncthreads();
            if (c.tid == 0) *slot = __hip_atomic_fetch_add(qw, 16u, __ATOMIC_RELAXED, __HIP_MEMORY_SCOPE_AGENT);
            __syncthreads();
            const unsigned base = *slot;
            if (base >= (unsigned)(IT_ALL - IT_SMALL)) break;
            const float *Wa, *Wb; int la, lb, sa, sb2, ka, kb2; unsigned char *Ta, *Tb; size_t da, db;
            f8item_addr(c, (int)base + c.wave, Wa, la, sa, ka, Ta, da); f8item_addr(c, (int)base + 8 + c.wave, Wb, lb, sb2, kb2, Tb, db);
            f32x4 ra[8], rb[8];
            f8item_load(Wa, la, sa, ka, c.lane, ra); f8item_load(Wb, lb, sb2, kb2, c.lane, rb);
            f8item_emit(ra, Ta, da, ka, scr, c.lane); f8item_emit(rb, Tb, db, kb2, scr, c.lane);
        }
    }
}

__device__ __forceinline__ void ph_gemm_inproj(const Ctx& c) {
    pg8::Sched S; S.init(c.H, c.win_t, nullptr, T / 256, NPROJ, c.G, c.bid, (size_t)D * 2);
    pg8::gemm_phase(c.lds, S, pg8::EpiProj{c.PROJ, NPROJ});
}
__device__ __forceinline__ void ph_gemm_outproj(const Ctx& c) {
    pg8::Sched S; S.init(c.H, c.wout_t, nullptr, T / 256, D, c.G, c.bid, (size_t)D * 2);
    pg8::gemm_phase(c.lds, S, pg8::EpiResid{c.x, c.mod, c.X1});
}
__device__ __forceinline__ void ph_gemm_up(const Ctx& c) {
    const int nmt = __builtin_amdgcn_readfirstlane(c.meta[0]);
    pg8::Sched S; S.init(c.XS8, c.w1_q, c.tile_e, nmt, 4096, c.G, c.bid, (size_t)D);
    pg8::gemm_phase_f8(c.lds, S, pg8::EpiUpF8{c.ACT8, c.b1, c.tile_e});
}
__device__ __forceinline__ void ph_gemm_down(const Ctx& c) {
    const int nmt = __builtin_amdgcn_readfirstlane(c.meta[0]);
    pg8::Sched S; S.init(c.ACT8, c.w2_q, c.tile_e, nmt, D, c.G, c.bid, (size_t)D);
    pg8::gemm_phase_f8(c.lds, S, pg8::EpiDown{c.Y, c.b2, c.tile_e, c.row_gate});
}

struct Args { const void* in[22]; float* out; unsigned char* ws; int ph_lo, ph_hi, li, pad; };
__global__ void __launch_bounds__(NTHREADS, 2) fwd_kernel(Args a) {
    extern __shared__ __attribute__((aligned(16))) unsigned char lds_raw[];
    Ctx c;
    c.lds = (LAS unsigned char*)lds_raw;
    c.tid = threadIdx.x; c.lane = c.tid & 63; c.wave = __builtin_amdgcn_readfirstlane(c.tid >> 6); c.G = gridDim.x; c.bid = blockIdx.x;
    c.x = (const float*)a.in[0]; c.c_in = (const float*)a.in[1]; c.positions = (const int*)a.in[2];
    c.ada_w = (const float*)a.in[3]; c.ada_b = (const float*)a.in[4]; c.norm1_g = (const float*)a.in[5]; c.w_in = (const float*)a.in[6]; c.conv_w = (const float*)a.in[7];
    c.a_log = (const float*)a.in[8]; c.dt_bias = (const float*)a.in[9]; c.gdn_norm_g = (const float*)a.in[10]; c.ret_norm_g = (const float*)a.in[11]; c.ret_norm_b = (const float*)a.in[12];
    c.w_out = (const float*)a.in[13]; c.norm2_g = (const float*)a.in[14]; c.w_router = (const float*)a.in[15]; c.b_router = (const float*)a.in[16];
    c.w1 = (const float*)a.in[17]; c.b1 = (const float*)a.in[18]; c.w2 = (const float*)a.in[19]; c.b2 = (const float*)a.in[20]; c.final_g = (const float*)a.in[21];
    c.out = a.out;
    unsigned char* ws = a.ws;
    c.ctl = (unsigned*)(ws + WS_CTL); c.mod = (float*)(ws + WS_MOD); c.tok_e = (int*)(ws + WS_TOKE); c.tok_g = (float*)(ws + WS_TOKG); c.tok_pos = (int*)(ws + WS_TOKP); c.blk_cnt = (int*)(ws + WS_BCNT);
    c.tile_e = (int*)(ws + WS_TILEE); c.meta = (int*)(ws + WS_META); c.row_gate = (float*)(ws + WS_RGATE); c.row_tok = (int*)(ws + WS_RTOK);
    c.ba = (float*)(ws + WS_BA); c.wba_t = (float*)(ws + WS_WBAT); c.wr_t = (float*)(ws + WS_WRT);
    c.win_t = (bf16*)(ws + WS_WIN); c.wout_t = (bf16*)(ws + WS_WOUT); c.w1_q = ws + WS_W1; c.w2_q = ws + WS_W2;
    c.H = (bf16*)(ws + WS_H); c.PROJ = (bf16*)(ws + WS_PROJ); c.Y = (bf16*)(ws + WS_Y); c.H8 = ws + WS_H + 32 * MiB; c.XS8 = ws + WS_XS; c.ACT8 = ws + WS_ACT;
    c.O = (float*)(ws + WS_O); c.Ob = (bf16*)(ws + WS_O); c.X1 = (bf16*)(ws + WS_X1);
    c.gimg = ws + WS_GIMG; c.rimg = ws + WS_RIMG; c.rvf = ws + WS_RVF; c.gu = (float*)(ws + WS_GU); c.rinner = (float*)(ws + WS_RINNER); c.gcd = (float*)(ws + WS_GCD); c.rot = (f32x2*)(ws + WS_ROT);

    volatile LAS unsigned* misc = (volatile LAS unsigned*)(c.lds + MISC_OFF);
    if (c.tid < 16) misc[c.tid] = 0u;
    __syncthreads();
    XcdBarrier bar; bar.bar = (unsigned*)(ws + WS_CTL) + CW_BAR + a.li * XCD_BAR_WORDS; bar.x = 0; bar.st = misc;
    if (N_LAUNCH_MODE == 1) bar = xcd_barrier_post((unsigned*)(ws + WS_CTL) + CW_BAR + a.li * XCD_BAR_WORDS, misc);
    const int lo = a.ph_lo, hi = a.ph_hi;
#ifdef ONLY_PHASE
#define IN(k) ((k) == ONLY_PHASE && lo <= (k) && (k) < hi)
#else
#define IN(k) (lo <= (k) && (k) < hi)
#endif
#define SEAM(k) do { if (N_LAUNCH_MODE == 1 && IN(k) && IN((k) + 1)) xcd_barrier(bar); else __syncthreads(); } while (0)
    if (IN(0)) { ph_prologue(c); } SEAM(0);
    if (IN(1)) { ph_norm1(c); } SEAM(1);
    if (IN(2)) { ph_gemm_inproj(c); } SEAM(2);
#if NAIVE_MIXER
    if (IN(3)) { } SEAM(3);
    if (IN(4)) { ph_mixer_naive(c); } SEAM(4);
#else
    if (IN(3)) { ph_mixer_prep(c); } SEAM(3);
    if (IN(4)) { ph_mixer_scan(c); } SEAM(4);
#endif
    if (IN(5)) { ph_gatenorm(c); } SEAM(5);
    if (IN(6)) { ph_gemm_outproj(c); } SEAM(6);
    if (IN(7)) { ph_router(c); } SEAM(7);
    if (IN(8)) { ph_route2(c); } SEAM(8);
    if (IN(9)) { ph_gemm_up(c); } SEAM(9);
    if (IN(10)) { ph_gemm_down(c); } SEAM(10);
    if (IN(11)) { ph_final(c); }
#undef IN
#undef SEAM
}

extern "C" void kernel_launch(void* const* d_in, const int* in_sizes, int n_in, void* d_out, int out_size, void* d_ws, size_t ws_size, hipStream_t stream) {
    static int grid = 0;
    if (grid == 0) {
        if (n_in != 22 || out_size != T * D || ws_size < WS_END) { fprintf(stderr, "kernel_launch: unexpected shapes (n_in %d out %d ws %zu)\n", n_in, out_size, ws_size); grid = -1; return; }
        int dev = 0, cus = 0, per_cu = 0;
        if (hipGetDevice(&dev) != hipSuccess || hipDeviceGetAttribute(&cus, hipDeviceAttributeMultiprocessorCount, dev) != hipSuccess) { grid = -1; return; }
        if (hipFuncSetAttribute((const void*)fwd_kernel, hipFuncAttributeMaxDynamicSharedMemorySize, LDS_BYTES) != hipSuccess) { fprintf(stderr, "kernel_launch: hipFuncSetAttribute failed\n"); grid = -1; return; }
        if (hipOccupancyMaxActiveBlocksPerMultiprocessor(&per_cu, (const void*)fwd_kernel, NTHREADS, LDS_BYTES) != hipSuccess || per_cu < 1) fprintf(stderr, "kernel_launch: occupancy query says %d\n", per_cu);
        (void)hipGetLastError();
        grid = cus;
    }
    if (grid < 0) return;
    (void)hipMemsetAsync((char*)d_ws + WS_CTL, 0, CTL_ZERO_BYTES, stream);
    Args a{};
    for (int i = 0; i < 22; ++i) a.in[i] = d_in[i];
    a.out = (float*)d_out; a.ws = (unsigned char*)d_ws;
#ifdef PROBE_DUP
    a.ph_lo = 0; a.ph_hi = PROBE_DUP + 1; a.li = 0; hipLaunchKernelGGL(fwd_kernel, dim3(grid), dim3(NTHREADS), LDS_BYTES, stream, a);
    a.ph_lo = PROBE_DUP; a.ph_hi = NPHASES; a.li = 1; hipLaunchKernelGGL(fwd_kernel, dim3(grid), dim3(NTHREADS), LDS_BYTES, stream, a);
    return;
#endif
    if (N_LAUNCH_MODE == 1) { a.ph_lo = 0; a.ph_hi = NPHASES; hipLaunchKernelGGL(fwd_kernel, dim3(grid), dim3(NTHREADS), LDS_BYTES, stream, a); }
    else for (int p = 0; p < NPHASES; ++p) { if (p == 3) continue; a.ph_lo = p; a.ph_hi = p + 1; hipLaunchKernelGGL(fwd_kernel, dim3(grid), dim3(NTHREADS), LDS_BYTES, stream, a); }
}
```

```cpp
#include <hip/hip_runtime.h>
#include <cstdio>
#include <cstdint>

#ifndef N_LAUNCH_MODE
#define N_LAUNCH_MODE 1
#endif
#ifndef NAIVE_GEMM
#define NAIVE_GEMM 0
#endif
#ifndef NAIVE_MIXER
#define NAIVE_MIXER 0
#endif

#define GAS __attribute__((address_space(1)))
#define LAS __attribute__((address_space(3)))
typedef unsigned short bf16;
typedef unsigned v4u __attribute__((ext_vector_type(4)));
typedef unsigned v2u __attribute__((ext_vector_type(2)));
typedef float f32x4 __attribute__((ext_vector_type(4)));
typedef float f32x2 __attribute__((ext_vector_type(2)));
typedef short bf16x8 __attribute__((ext_vector_type(8)));

constexpr int NB = 4, SEQ = 4096, T = NB * SEQ, D = 2048;
constexpr int GH = 8, GDK = 128, RH = 4, RDK = 256;
constexpr int NE = 32, TOPK = 4;
constexpr int INC = 8208, NPROJ = 8192, MODW = 6 * D;
constexpr int MAXROWS = T * TOPK + NE * 256;
constexpr float EPS = 1e-6f;
constexpr int NTHREADS = 512, NWAVES = 8;
constexpr int NPHASES = 12;

constexpr size_t MiB = 1u << 20;
constexpr size_t WS_CTL = 0, CTL_ZERO_BYTES = 2 * MiB;
constexpr size_t WS_MOD = 1 * MiB;
constexpr size_t WS_TOKE = 2 * MiB;
constexpr size_t WS_TOKG = WS_TOKE + 256 * 1024;
constexpr size_t WS_TOKP = WS_TOKG + 256 * 1024;
constexpr size_t WS_BCNT = WS_TOKP + 256 * 1024;
constexpr size_t WS_TILEE = WS_BCNT + 128 * 1024;
constexpr size_t WS_META = WS_TILEE + 4096;
constexpr size_t WS_RGATE = 3 * MiB;
constexpr size_t WS_RTOK = 3 * MiB + 512 * 1024;
constexpr size_t WS_BA = 4 * MiB;
constexpr size_t WS_WBAT = 5 * MiB;
constexpr size_t WS_WRT = 5 * MiB + 256 * 1024;
constexpr size_t WS_WIN = 8 * MiB;
constexpr size_t WS_WOUT = 40 * MiB;
constexpr size_t WS_W1 = 48 * MiB;
constexpr size_t WS_W2 = 560 * MiB;
constexpr size_t WS_H = 816 * MiB;
constexpr size_t WS_PROJ = 880 * MiB;
constexpr size_t WS_O = 1136 * MiB;
constexpr size_t WS_X1 = 1264 * MiB;
constexpr size_t WS_XS = 1392 * MiB;
constexpr size_t WS_ACT = 1680 * MiB;
constexpr size_t WS_Y = 1968 * MiB;
constexpr size_t WS_GIMG = 2256 * MiB;
constexpr size_t WS_GU = 2368 * MiB;
constexpr size_t WS_RIMG = 2432 * MiB;
constexpr size_t WS_RINNER = 2496 * MiB;
constexpr size_t WS_RVF = 2560 * MiB;
constexpr size_t WS_GCD = 2592 * MiB;
constexpr size_t WS_ROT = 2593 * MiB;
constexpr size_t WS_END = 2609 * MiB;
constexpr int GIMG_BYTES = 57344, RIMG_BYTES = 65536;
constexpr int CW_BAR = 4096;
constexpr int CW_CONVQ = 64;

constexpr int LDS_BYTES = 160 * 1024;
constexpr int MISC_OFF = LDS_BYTES - 256;

#define LDS_WAIT() asm volatile("s_waitcnt lgkmcnt(0)" ::: "memory")
#define VM_WAIT() asm volatile("s_waitcnt vmcnt(0)" ::: "memory")
typedef __bf16 bf16v2_t __attribute__((ext_vector_type(2)));
__device__ __forceinline__ unsigned cvt2(float lo, float hi) { const f32x2 v = {lo, hi}; return __builtin_bit_cast(unsigned, __builtin_convertvector(v, bf16v2_t)); }
__device__ __forceinline__ unsigned pk2(float lo, float hi) { return cvt2(lo, hi); }
__device__ __forceinline__ unsigned f2bf(float f) { return (unsigned)__builtin_bit_cast(unsigned short, (__bf16)f); }
__device__ __forceinline__ float bf2f(unsigned b) { return __uint_as_float(b << 16); }
__device__ __forceinline__ float bflo(unsigned w) { return __uint_as_float(w << 16); }
__device__ __forceinline__ float bfhi(unsigned w) { return __uint_as_float(w & 0xffff0000u); }
__device__ __forceinline__ float wave_sum(float v) {
#pragma unroll
    for (int o = 1; o < 64; o <<= 1) v += __shfl_xor(v, o);
    return v;
}
__device__ __forceinline__ void lds_inc(LAS int* p) { (void)__hip_atomic_fetch_add(p, 1, __ATOMIC_RELAXED, __HIP_MEMORY_SCOPE_WORKGROUP); }
__device__ __forceinline__ float siluf(float v) { return v / (1.f + __expf(-v)); }
__device__ __forceinline__ float sigmoidf_(float v) { return 1.f / (1.f + __expf(-v)); }
__device__ __forceinline__ float softplusf_(float v) { return v > 20.f ? v : log1pf(expf(v)); }

#define XB_TMO      128
#define XB_XCNT(j)  (256  + 64 * (j))
#define XB_XSUB(j)  (1280 + 64 * (j))
#define XB_XGEN(j)  (2304 + 64 * (j))
#define XB_TOP      3328
#define XB_TOPGEN   3392
#define XCD_BAR_WORDS 3456
#define XB_SPIN_CAP (1u << 24)
__device__ __forceinline__ unsigned xb_ld(unsigned* p)              { return __hip_atomic_load(p, __ATOMIC_RELAXED, __HIP_MEMORY_SCOPE_AGENT); }
__device__ __forceinline__ unsigned xb_add(unsigned* p, unsigned v) { return __hip_atomic_fetch_add(p, v, __ATOMIC_RELAXED, __HIP_MEMORY_SCOPE_AGENT); }
__device__ __forceinline__ unsigned xb_xcc_id() { return (unsigned)__builtin_amdgcn_s_getreg((3 << 11) | 20) & 0xFu; }
#define XB_SPIN(cond, bar) do { unsigned _sp = 0; while (cond) { __builtin_amdgcn_s_sleep(1); \
    if ((++_sp & 255u) == 0u) { if (xb_ld(&(bar)[XB_TMO])) break; if (_sp > XB_SPIN_CAP) { atomicAdd(&(bar)[XB_TMO], 1u); break; } } } } while (0)
struct XcdBarrier { unsigned* bar; unsigned x; volatile LAS unsigned* st; };
__device__ __forceinline__ XcdBarrier xcd_barrier_post(unsigned* bar, volatile LAS unsigned* st) {
    XcdBarrier b; b.bar = bar; b.x = xb_xcc_id(); b.st = st;
    if (threadIdx.x == 0) (void)xb_add(&bar[XB_XCNT(b.x)], 1u);
    return b;
}
__device__ __forceinline__ void xcd_barrier_complete(unsigned* bar, unsigned x, unsigned& nloc, unsigned& nx) {
    const unsigned G = gridDim.x * gridDim.y * gridDim.z;
    unsigned sum, cnt, mine, sp = 0u;
    for (;;) {
        sum = 0u; cnt = 0u; mine = 0u;
#pragma unroll
        for (unsigned j = 0; j < 16; ++j) { const unsigned c = xb_ld(&bar[XB_XCNT(j)]); sum += c; cnt += (c > 0u) ? 1u : 0u; mine = (j == x) ? c : mine; }
        if (sum == G) break;
        __builtin_amdgcn_s_sleep(1);
        if ((++sp & 255u) == 0u) { if (xb_ld(&bar[XB_TMO])) break; if (sp > XB_SPIN_CAP) { atomicAdd(&bar[XB_TMO], 1u); break; } }
    }
    nloc = mine > 0u ? mine : 1u; nx = cnt > 0u ? cnt : 1u;
}
__device__ __forceinline__ void xcd_barrier(const XcdBarrier& b) {
    asm volatile("s_waitcnt vmcnt(0)" ::: "memory");
    __syncthreads();
    if (threadIdx.x == 0) {
        unsigned* bar = b.bar;
        __builtin_amdgcn_s_waitcnt(0);
        unsigned nloc = b.st[0], nx = b.st[1];
        if (nloc == 0u) { xcd_barrier_complete(bar, b.x, nloc, nx); b.st[0] = nloc; b.st[1] = nx; }
        const unsigned old = xb_add(&bar[XB_XSUB(b.x)], 1u);
        const unsigned gen = old / nloc;
        if (old + 1u == (gen + 1u) * nloc) {
            __builtin_amdgcn_fence(__ATOMIC_RELEASE, "agent");
            asm volatile("s_waitcnt vmcnt(0)" ::: "memory");
            const unsigned og = xb_add(&bar[XB_TOP], 1u);
            const unsigned tg = og / nx;
            if (og + 1u == (tg + 1u) * nx) xb_add(&bar[XB_TOPGEN], 1u);
            else XB_SPIN(xb_ld(&bar[XB_TOPGEN]) == tg, bar);
            __builtin_amdgcn_fence(__ATOMIC_ACQUIRE, "agent");
            xb_add(&bar[XB_XGEN(b.x)], 1u);
            asm volatile("s_waitcnt vmcnt(0)" ::: "memory");
        } else {
            XB_SPIN(xb_ld(&bar[XB_XGEN(b.x)]) == gen, bar);
            __builtin_amdgcn_fence(__ATOMIC_ACQUIRE, "agent");
            asm volatile("s_waitcnt vmcnt(0)" ::: "memory");
        }
    }
    __syncthreads();
}

struct Ctx {
    LAS unsigned char* lds;
    int tid, lane, wave, G, bid;
    const float *x, *c_in; const int* positions;
    const float *ada_w, *ada_b, *norm1_g, *w_in, *conv_w, *a_log, *dt_bias, *gdn_norm_g, *ret_norm_g, *ret_norm_b, *w_out, *norm2_g, *w_router, *b_router, *w1, *b1, *w2, *b2, *final_g;
    float* out;
    unsigned* ctl; float* mod; int* tok_e; float* tok_g; int* tok_pos; int* blk_cnt; int* tile_e; int* meta; float* row_gate; int* row_tok;
    float* ba; float* wba_t; float* wr_t;
    bf16 *win_t, *wout_t, *H, *PROJ, *Y;
    unsigned char *w1_q, *w2_q, *H8, *XS8, *ACT8;
    float *O; bf16* X1; bf16* Ob;
    unsigned char *gimg, *rimg, *rvf; float *gu, *rinner, *gcd; f32x2* rot;
};

__device__ __forceinline__ void ph_mod(const Ctx& c) {
    LAS float* cond = (LAS float*)(c.lds);
    LAS float* red = (LAS float*)(c.lds + 32768);
    bool did = false;
    for (int u = c.bid; u < MODW / 64; u += c.G) {
        if (!did) { for (int i = c.tid; i < NB * D; i += NTHREADS) { const float v = c.c_in[i]; cond[i] = v / (1.f + expf(-v)); } __syncthreads(); did = true; }
        const int col = u * 64 + c.lane, kbase = c.wave * 256;
        float acc[4] = {0.f, 0.f, 0.f, 0.f};
        const float* wp = c.ada_w + (size_t)kbase * MODW + col;
#pragma unroll 16
        for (int k = 0; k < 256; ++k) {
            const float w = wp[(size_t)k * MODW];
#pragma unroll
            for (int b = 0; b < 4; ++b) acc[b] += cond[b * D + kbase + k] * w;
        }
#pragma unroll
        for (int b = 0; b < 4; ++b) red[(c.wave * 4 + b) * 64 + c.lane] = acc[b];
        __syncthreads();
        if (c.tid < 256) { const int b = c.tid >> 6, cc = c.tid & 63; float s = c.ada_b[u * 64 + cc];
#pragma unroll
            for (int w = 0; w < 8; ++w) s += red[(w * 4 + b) * 64 + cc];
            c.mod[b * MODW + u * 64 + cc] = s; }
        __syncthreads();
    }
}
__device__ __forceinline__ void transpose_item(const float* W, int ldw, int scol0, int k0, bf16* WT, size_t drow0, int ldk, LAS float* scr, int lane) {
#pragma unroll 8
    for (int i = 0; i < 32; ++i) { const int kk = 2 * i + (lane >> 5); scr[kk * 33 + (lane & 31)] = W[(size_t)(k0 + kk) * ldw + scol0 + (lane & 31)]; }
    LDS_WAIT(); asm volatile("" ::: "memory");
    const int cch = lane & 7;
#pragma unroll
    for (int j = 0; j < 4; ++j) { const int n = (lane >> 3) + 8 * j; const LAS float* s = scr + (8 * cch) * 33 + n;
        v4u o; o.x = pk2(s[0 * 33], s[1 * 33]); o.y = pk2(s[2 * 33], s[3 * 33]); o.z = pk2(s[4 * 33], s[5 * 33]); o.w = pk2(s[6 * 33], s[7 * 33]);
        *(GAS v4u*)(WT + (drow0 + n) * ldk + k0 + 8 * cch) = o; }
    LDS_WAIT(); asm volatile("" ::: "memory");
}
__device__ __forceinline__ unsigned pk4_fp8(float a, float b, float c2, float d) {
    a = fminf(fmaxf(a, -448.f), 448.f); b = fminf(fmaxf(b, -448.f), 448.f); c2 = fminf(fmaxf(c2, -448.f), 448.f); d = fminf(fmaxf(d, -448.f), 448.f);
    int w = 0; w = __builtin_amdgcn_cvt_pk_fp8_f32(a, b, w, false); w = __builtin_amdgcn_cvt_pk_fp8_f32(c2, d, w, true); return (unsigned)w;
}
__device__ __forceinline__ unsigned pk4_fp8_nc(float a, float b, float c2, float d) {
    int w = 0; w = __builtin_amdgcn_cvt_pk_fp8_f32(a, b, w, false); w = __builtin_amdgcn_cvt_pk_fp8_f32(c2, d, w, true); return (unsigned)w;
}
constexpr float W8_SCALE = 256.f;
__device__ __forceinline__ void transpose_item_f8(const float* W, int ldw, int scol0, int k0, unsigned char* WT, size_t drow0, int ldk, LAS float* scr, int lane) {
#pragma unroll 8
    for (int i = 0; i < 32; ++i) { const int kk = 2 * i + (lane >> 5); scr[kk * 33 + (lane & 31)] = W[(size_t)(k0 + kk) * ldw + scol0 + (lane & 31)]; }
    LDS_WAIT(); asm volatile("" ::: "memory");
    const int cch = lane & 7;
#pragma unroll
    for (int j = 0; j < 4; ++j) { const int n = (lane >> 3) + 8 * j; const LAS float* s = scr + (8 * cch) * 33 + n;
        v2u o; o.x = pk4_fp8(s[0 * 33] * W8_SCALE, s[1 * 33] * W8_SCALE, s[2 * 33] * W8_SCALE, s[3 * 33] * W8_SCALE); o.y = pk4_fp8(s[4 * 33] * W8_SCALE, s[5 * 33] * W8_SCALE, s[6 * 33] * W8_SCALE, s[7 * 33] * W8_SCALE);
        *(GAS v2u*)(WT + (drow0 + n) * ldk + k0 + 8 * cch) = o; }
    LDS_WAIT(); asm volatile("" ::: "memory");
}
__device__ __forceinline__ void f8item_addr(const Ctx& c, int r, const float*& W, int& ldw, int& scol, int& k0, unsigned char*& WT, size_t& drow0) {
    if (r < 32 * 32 * 128) { const int e = r >> 12, kb = (r >> 7) & 31, nb = r & 127, n0 = 32 * nb; scol = ((n0 >> 7) & 1) * 2048 + (n0 >> 8) * 128 + (n0 & 127);
        W = c.w1 + (size_t)e * D * 4096; ldw = 4096; k0 = 64 * kb; WT = c.w1_q; drow0 = (size_t)e * 4096 + n0; }
    else { r -= 32 * 32 * 128; const int e = r >> 11, kb = (r >> 6) & 31, nb = r & 63; scol = 32 * nb; W = c.w2 + (size_t)e * D * D; ldw = D; k0 = 64 * kb; WT = c.w2_q; drow0 = (size_t)e * D + 32 * nb; }
}
__device__ __forceinline__ void f8item_load(const float* W, int ldw, int scol, int k0, int lane, f32x4 (&rg)[8]) {
    const float* p = W + (size_t)(k0 + (lane >> 3)) * ldw + scol + 4 * (lane & 7);
#pragma unroll
    for (int i = 0; i < 8; ++i) rg[i] = *(const f32x4*)(p + (size_t)(8 * i) * ldw);
}
__device__ __forceinline__ void f8item_emit(const f32x4 (&rg)[8], unsigned char* WT, size_t drow0, int k0, LAS float* scr, int lane) {
#pragma unroll
    for (int i = 0; i < 8; ++i) { LAS float* d = scr + (8 * i + (lane >> 3)) * 33 + 4 * (lane & 7); d[0] = rg[i].x; d[1] = rg[i].y; d[2] = rg[i].z; d[3] = rg[i].w; }
    LDS_WAIT(); asm volatile("" ::: "memory");
    const int cch = lane & 7;
#pragma unroll
    for (int j = 0; j < 4; ++j) { const int n = (lane >> 3) + 8 * j; const LAS float* s = scr + (8 * cch) * 33 + n;
        v2u o; o.x = pk4_fp8(s[0 * 33] * W8_SCALE, s[1 * 33] * W8_SCALE, s[2 * 33] * W8_SCALE, s[3 * 33] * W8_SCALE); o.y = pk4_fp8(s[4 * 33] * W8_SCALE, s[5 * 33] * W8_SCALE, s[6 * 33] * W8_SCALE, s[7 * 33] * W8_SCALE);
        *(GAS v2u*)(WT + (drow0 + n) * D + k0 + 8 * cch) = o; }
    LDS_WAIT(); asm volatile("" ::: "memory");
}
constexpr int IT_WIN = 32 * 256, IT_WOUT = 32 * 64, IT_W1 = 32 * 32 * 128, IT_W2 = 32 * 32 * 64;
constexpr int IT_SMALL = IT_WIN + IT_WOUT, IT_ALL = IT_SMALL + IT_W1 + IT_W2;
constexpr int SCAN_UNITS = 64;
__device__ __forceinline__ void convert_items(const Ctx& c, int it0, int it1, int wk, int nwk, LAS unsigned char* scrbase) {
    LAS float* scr = (LAS float*)(scrbase + c.wave * 8704);
    for (int it = it0 + wk; it < it1; it += nwk) {
        int r = it;
        if (r < IT_WIN) { const int kb = r >> 8, nb = r & 255, n0 = 32 * nb; transpose_item(c.w_in, INC, n0 < 4096 ? n0 : n0 + 16, 64 * kb, c.win_t, n0, D, scr, c.lane); continue; }
        r -= IT_WIN;
        if (r < IT_WOUT) { const int kb = r >> 6, nb = r & 63; transpose_item(c.w_out, D, 32 * nb, 64 * kb, c.wout_t, 32 * nb, D, scr, c.lane); continue; }
        r -= IT_WOUT;
        if (r < IT_W1) { const int e = r >> 12, kb = (r >> 7) & 31, nb = r & 127, n0 = 32 * nb; const int scol = ((n0 >> 7) & 1) * 2048 + (n0 >> 8) * 128 + (n0 & 127);
            transpose_item_f8(c.w1 + (size_t)e * D * 4096, 4096, scol, 64 * kb, c.w1_q, (size_t)e * 4096 + n0, D, scr, c.lane); continue; }
        r -= IT_W1;
        { const int e = r >> 11, kb = (r >> 6) & 31, nb = r & 63; transpose_item_f8(c.w2 + (size_t)e * D * D, D, 32 * nb, 64 * kb, c.w2_q, (size_t)e * D + 32 * nb, D, scr, c.lane); }
    }
}
__device__ __forceinline__ void ph_prologue(const Ctx& c) {
    ph_mod(c);
    __syncthreads();
    for (int i = c.bid * NTHREADS + c.tid; i < 16 * D; i += c.G * NTHREADS) { const int k = i >> 4, j = i & 15; c.wba_t[j * D + k] = c.w_in[(size_t)k * INC + 4096 + j]; }
    for (int i = c.bid * NTHREADS + c.tid; i < 32 * D; i += c.G * NTHREADS) { const int k = i >> 5, e = i & 31; c.wr_t[e * D + k] = c.w_router[k * 32 + e]; }
    for (int i = c.bid * NTHREADS + c.tid; i < T * 128; i += c.G * NTHREADS) { const int t = i >> 7, j = i & 127;
        const float invf = exp2f(-(float)j * (13.287712379549449f / 127.f)); float sn, cs; sincosf((float)c.positions[t] * invf, &sn, &cs); c.rot[i] = (f32x2){cs, sn}; }
    convert_items(c, 0, c.G > SCAN_UNITS ? IT_SMALL : IT_ALL, c.bid * NWAVES + c.wave, c.G * NWAVES, c.lds);
}

__device__ __forceinline__ int tokens_per_block(int G);
__device__ __forceinline__ void ph_norm1(const Ctx& c) {
    constexpr int RSB = 2056;
    LAS bf16* hH = (LAS bf16*)c.lds;
    LAS bf16* hL = hH + 16 * RSB;
    LAS float* part = (LAS float*)(c.lds + 2 * 16 * RSB * 2);
    LAS float* GpL = part + 2048;
    LAS float* ShL = GpL + 2048;
    const int TPB = tokens_per_block(c.G), base = c.bid * TPB;
    const int lane = c.lane, w = c.wave, fi = lane & 15, kq = lane >> 4;
    if (base >= T) return;
    f32x4 xn[2][8];
    { const int m0 = base + 2 * w; const int mr = m0 < T ? m0 : 0;
#pragma unroll
      for (int r = 0; r < 2; ++r) { const float* xr = c.x + (size_t)(mr + r) * D + 8 * lane;
#pragma unroll
          for (int j = 0; j < 4; ++j) { xn[r][2 * j] = *(const f32x4*)(xr + 512 * j); xn[r][2 * j + 1] = *(const f32x4*)(xr + 512 * j + 4); } } }
    bf16x8 wbH[8], wbL[8];
    { const float* bp = c.wba_t + (size_t)fi * D + 256 * w + 8 * kq;
#pragma unroll
      for (int s2 = 0; s2 < 8; ++s2) { const f32x4 f0 = *(const f32x4*)(bp + 32 * s2), f1 = *(const f32x4*)(bp + 32 * s2 + 4);
          const unsigned h0 = cvt2(f0.x, f0.y), h1 = cvt2(f0.z, f0.w), h2 = cvt2(f1.x, f1.y), h3 = cvt2(f1.z, f1.w);
          const unsigned l0 = cvt2(f0.x - bflo(h0), f0.y - bfhi(h0)), l1 = cvt2(f0.z - bflo(h1), f0.w - bfhi(h1)), l2 = cvt2(f1.x - bflo(h2), f1.y - bfhi(h2)), l3 = cvt2(f1.z - bflo(h3), f1.w - bfhi(h3));
          wbH[s2] = __builtin_bit_cast(bf16x8, (v4u){h0, h1, h2, h3}); wbL[s2] = __builtin_bit_cast(bf16x8, (v4u){l0, l1, l2, l3}); } }
    int cbat = -1;
    for (int p0 = 0; p0 < TPB; p0 += 16) {
        if (base + p0 >= T) break;
        const int bat = (base + p0) >> 12;
        if (bat != cbat) {
            cbat = bat; __syncthreads();
            const float* mb = c.mod + bat * MODW; const int col = 4 * c.tid;
            const f32x4 g = *(const f32x4*)(c.norm1_g + col), sc = *(const f32x4*)(mb + D + col), sh = *(const f32x4*)(mb + col);
            *(LAS f32x4*)(GpL + col) = g * (1.f + sc); *(LAS f32x4*)(ShL + col) = sh;
            __syncthreads();
        }
        {
            const int m0 = base + p0 + 2 * w;
            const bool ok = m0 < T;
            const int mr = ok ? m0 : 0;
#pragma unroll
            for (int r = 0; r < 2; ++r) {
                float ss = 0.f;
#pragma unroll
                for (int j = 0; j < 8; ++j) ss += (xn[r][j].x * xn[r][j].x + xn[r][j].y * xn[r][j].y) + (xn[r][j].z * xn[r][j].z + xn[r][j].w * xn[r][j].w);
                const float rstd = rsqrtf(wave_sum(ss) * (1.f / D) + EPS);
                v4u* o8 = (v4u*)(c.H + (size_t)(mr + r) * D) + lane; const int lo = (2 * w + r) * RSB + 8 * lane;
#pragma unroll
                for (int j = 0; j < 4; ++j) { const int col = 8 * lane + 512 * j;
                    const f32x4 gp0 = *(const LAS f32x4*)(GpL + col), gp1 = *(const LAS f32x4*)(GpL + col + 4), sh0 = *(const LAS f32x4*)(ShL + col), sh1 = *(const LAS f32x4*)(ShL + col + 4);
                    const f32x4 v0 = (xn[r][2 * j] * rstd) * gp0 + sh0, v1 = (xn[r][2 * j + 1] * rstd) * gp1 + sh1;
                    v4u hw, lw; hw.x = cvt2(v0.x, v0.y); hw.y = cvt2(v0.z, v0.w); hw.z = cvt2(v1.x, v1.y); hw.w = cvt2(v1.z, v1.w);
                    lw.x = cvt2(v0.x - bflo(hw.x), v0.y - bfhi(hw.x)); lw.y = cvt2(v0.z - bflo(hw.y), v0.w - bfhi(hw.y)); lw.z = cvt2(v1.x - bflo(hw.z), v1.y - bfhi(hw.z)); lw.w = cvt2(v1.z - bflo(hw.w), v1.w - bfhi(hw.w));
                    if (ok) o8[64 * j] = hw;
                    *(LAS v4u*)(hH + lo + 512 * j) = hw; *(LAS v4u*)(hL + lo + 512 * j) = lw; }
            }
            const int m1 = m0 + 16;
            if (p0 + 16 < TPB && m1 < T) {
#pragma unroll
                for (int r = 0; r < 2; ++r) { const float* xr = c.x + (size_t)(m1 + r) * D + 8 * lane;
#pragma unroll
                    for (int j = 0; j < 4; ++j) { xn[r][2 * j] = *(const f32x4*)(xr + 512 * j); xn[r][2 * j + 1] = *(const f32x4*)(xr + 512 * j + 4); } } }
        }
        __syncthreads();
        {
            f32x4 aHH = {0.f, 0.f, 0.f, 0.f}, aHL = {0.f, 0.f, 0.f, 0.f}, aLH = {0.f, 0.f, 0.f, 0.f};
            const int ao = fi * RSB + 256 * w + 8 * kq;
#pragma unroll
            for (int s2 = 0; s2 < 8; ++s2) {
                const bf16x8 ah = *(const LAS bf16x8*)(hH + ao + 32 * s2), al = *(const LAS bf16x8*)(hL + ao + 32 * s2);
                aHH = __builtin_amdgcn_mfma_f32_16x16x32_bf16(ah, wbH[s2], aHH, 0, 0, 0); aHL = __builtin_amdgcn_mfma_f32_16x16x32_bf16(ah, wbL[s2], aHL, 0, 0, 0); aLH = __builtin_amdgcn_mfma_f32_16x16x32_bf16(al, wbH[s2], aLH, 0, 0, 0);
            }
            *(LAS f32x4*)(part + (w * 64 + lane) * 4) = aHH + (aHL + aLH);
        }
        __syncthreads();
        if (c.tid < 256) {
            const int i = c.tid >> 4, n = c.tid & 15; float sacc = 0.f;
            const LAS float* pp = part + ((i >> 2) * 16 + n) * 4 + (i & 3);
#pragma unroll
            for (int ww = 0; ww < 8; ++ww) sacc += pp[ww * 256];
            if (base + p0 + i < T) c.ba[(size_t)(base + p0 + i) * 16 + n] = sacc;
        }
    }
}

template <class ARow, class BRow, class Epi>
__device__ __forceinline__ void naive_gemm(const Ctx& c, int nMt, int nNt, int K, const ARow& arow, const BRow& brow, const Epi& epi) {
    LAS float* As = (LAS float*)c.lds;
    LAS float* Bs = As + 32 * 68;
    const int tid = c.tid, ty = tid >> 5, tx = tid & 31;
    for (int u = c.bid; u < nMt * nNt; u += c.G) {
        const int mt = u / nNt, nt = u % nNt;
        float acc[4][8];
#pragma unroll
        for (int r = 0; r < 4; ++r)
#pragma unroll
            for (int i = 0; i < 8; ++i) acc[r][i] = 0.f;
        for (int k0 = 0; k0 < K; k0 += 32) {
            if (tid < 256) { const int r = tid >> 2, kc = (tid & 3) * 8; const v4u w = *(const v4u*)(arow(mt * 64 + r) + k0 + kc);
                As[(kc + 0) * 68 + r] = bflo(w.x); As[(kc + 1) * 68 + r] = bfhi(w.x); As[(kc + 2) * 68 + r] = bflo(w.y); As[(kc + 3) * 68 + r] = bfhi(w.y);
                As[(kc + 4) * 68 + r] = bflo(w.z); As[(kc + 5) * 68 + r] = bfhi(w.z); As[(kc + 6) * 68 + r] = bflo(w.w); As[(kc + 7) * 68 + r] = bfhi(w.w); }
            { const int n = tid >> 1, kc = (tid & 1) * 16; const bf16* bp = brow(mt, nt * 256 + n) + k0 + kc; const v4u w0 = *(const v4u*)bp, w1 = *(const v4u*)(bp + 8);
                LAS float* d = Bs + kc * 260 + n;
                d[0 * 260] = bflo(w0.x); d[1 * 260] = bfhi(w0.x); d[2 * 260] = bflo(w0.y); d[3 * 260] = bfhi(w0.y); d[4 * 260] = bflo(w0.z); d[5 * 260] = bfhi(w0.z); d[6 * 260] = bflo(w0.w); d[7 * 260] = bfhi(w0.w);
                d[8 * 260] = bflo(w1.x); d[9 * 260] = bfhi(w1.x); d[10 * 260] = bflo(w1.y); d[11 * 260] = bfhi(w1.y); d[12 * 260] = bflo(w1.z); d[13 * 260] = bfhi(w1.z); d[14 * 260] = bflo(w1.w); d[15 * 260] = bfhi(w1.w); }
            __syncthreads();
#pragma unroll 4
            for (int kk = 0; kk < 32; ++kk) { const f32x4 a = *(const LAS f32x4*)(As + kk * 68 + 4 * ty); float bv[8];
#pragma unroll
                for (int i = 0; i < 8; ++i) bv[i] = Bs[kk * 260 + tx + 32 * i];
#pragma unroll
                for (int i = 0; i < 8; ++i) { acc[0][i] += a.x * bv[i]; acc[1][i] += a.y * bv[i]; acc[2][i] += a.z * bv[i]; acc[3][i] += a.w * bv[i]; } }
            __syncthreads();
        }
#pragma unroll
        for (int r = 0; r < 4; ++r) epi(mt * 64 + 4 * ty + r, nt * 256, tx, acc[r]);
    }
}

__device__ __forceinline__ void naive_gdn(const Ctx& c, int b, int h) {
    LAS float* sq = (LAS float*)c.lds;
    LAS float* red = sq + 384;
    LAS float* nrm = red + 512;
    const int tid = c.tid, v = tid & 127, dq = tid >> 7;
    float S[32];
#pragma unroll
    for (int i = 0; i < 32; ++i) S[i] = 0.f;
    const float A = expf(c.a_log[h]), dtb = c.dt_bias[h];
    for (int t = 0; t < SEQ; ++t) {
        const size_t row = (size_t)b * SEQ + t;
        if (tid < 384) { const int mat = tid >> 7, ch = tid & 127, col = mat * 1024 + h * 128 + ch; float a = 0.f;
#pragma unroll
            for (int i = 0; i < 4; ++i) { const int tt = t - 3 + i; if (tt >= 0) a += c.conv_w[i * 3072 + col] * bf2f(c.PROJ[((size_t)b * SEQ + tt) * NPROJ + col]); }
            sq[tid] = siluf(a); }
        __syncthreads();
        if (c.wave < 2) { const float a0 = sq[c.wave * 128 + c.lane], a1 = sq[c.wave * 128 + 64 + c.lane]; const float s = wave_sum(a0 * a0 + a1 * a1); if (c.lane == 0) nrm[c.wave] = s; }
        __syncthreads();
        const float rq = rsqrtf(nrm[0] + EPS) * 0.08838834764831845f, rk = rsqrtf(nrm[1] + EPS);
        const float beta = sigmoidf_(c.ba[row * 16 + h]), gs = -A * softplusf_(c.ba[row * 16 + 8 + h] + dtb), a = expf(gs);
        float p = 0.f;
#pragma unroll
        for (int i = 0; i < 32; ++i) p += sq[128 + 32 * dq + i] * rk * S[i];
        red[dq * 128 + v] = p;
        __syncthreads();
        const float kS = (red[v] + red[128 + v]) + (red[256 + v] + red[384 + v]);
        const float vv = sq[256 + v];
        __syncthreads();
        float po = 0.f;
#pragma unroll
        for (int i = 0; i < 32; ++i) { const float kd = sq[128 + 32 * dq + i] * rk; S[i] = a * (S[i] - beta * kd * kS) + beta * kd * vv; po += sq[32 * dq + i] * rq * S[i]; }
        red[dq * 128 + v] = po;
        __syncthreads();
        if (dq == 0) c.O[row * D + h * 128 + v] = (red[v] + red[128 + v]) + (red[256 + v] + red[384 + v]);
        __syncthreads();
    }
}
__device__ __forceinline__ void naive_ret(const Ctx& c, int b, int h, int vh) {
    LAS float* sq = (LAS float*)c.lds;
    LAS float* red = sq + 640;
    const int tid = c.tid, v = tid & 127, dq = tid >> 7;
    float S[64];
#pragma unroll
    for (int i = 0; i < 64; ++i) S[i] = 0.f;
    const float gamma = 1.f - exp2f(-5.f - (float)h);
    for (int t = 0; t < SEQ; ++t) {
        const size_t row = (size_t)b * SEQ + t;
        if (tid < 256) { const int mat = tid >> 7, i = tid & 127; const int colb = 4096 + mat * 1024 + h * 256;
            const float x1 = bf2f(c.PROJ[row * NPROJ + colb + i]), x2 = bf2f(c.PROJ[row * NPROJ + colb + 128 + i]);
            const float invf = powf(10000.f, -(float)i / 127.f), ang = (float)c.positions[row] * invf; const float cs = cosf(ang), sn = sinf(ang);
            const float sc = mat ? 0.0625f : 1.f;
            sq[mat * 256 + i] = (x1 * cs - x2 * sn) * sc; sq[mat * 256 + 128 + i] = (x2 * cs + x1 * sn) * sc; }
        else if (tid < 384) { const int i = tid - 256; sq[512 + i] = bf2f(c.PROJ[row * NPROJ + 6144 + h * 256 + vh * 128 + i]); }
        __syncthreads();
        const float vv = sq[512 + v]; float po = 0.f;
#pragma unroll
        for (int i = 0; i < 64; ++i) { S[i] = gamma * S[i] + sq[256 + 64 * dq + i] * vv; po += sq[64 * dq + i] * S[i]; }
        red[dq * 128 + v] = po;
        __syncthreads();
        if (dq == 0) c.O[row * D + 1024 + h * 256 + vh * 128 + v] = (red[v] + red[128 + v]) + (red[256 + v] + red[384 + v]);
        __syncthreads();
    }
}
__device__ __forceinline__ void ph_mixer_naive(const Ctx& c) {
    for (int u = c.bid; u < 64; u += c.G) {
        if (u < 32) naive_gdn(c, u >> 3, u & 7);
        else { const int r = u - 32; naive_ret(c, r >> 3, (r >> 1) & 3, r & 1); }
    }
}

__device__ __forceinline__ void ph_gatenorm(const Ctx& c) {
    const int gw = c.bid * NWAVES + c.wave, NGW = c.G * NWAVES;
    v4u ow[4], zw[4];
    auto fetch = [&](int m, v4u (&o)[4], v4u (&z)[4]) {
        const v4u* orow = (const v4u*)(c.Ob + (size_t)m * D) + c.lane; const bf16* prow = c.PROJ + (size_t)m * NPROJ + 8 * c.lane;
#pragma unroll
        for (int j = 0; j < 4; ++j) { o[j] = orow[64 * j]; z[j] = *(const v4u*)(prow + (j < 2 ? 3072 + 512 * j : 7168 + 512 * (j - 2))); } };
    if (gw < T) fetch(gw, ow, zw);
    for (int m = gw; m < T; m += NGW) {
        v4u on[4], zn[4];
        const bool more = m + NGW < T;
        if (more) fetch(m + NGW, on, zn);
        v4u* o8 = (v4u*)(c.H + (size_t)m * D) + c.lane;
#pragma unroll
        for (int j = 0; j < 4; ++j) {
            const int col = 8 * c.lane + 512 * j;
            const f32x4 oa = {bflo(ow[j].x), bfhi(ow[j].x), bflo(ow[j].y), bfhi(ow[j].y)}, ob = {bflo(ow[j].z), bfhi(ow[j].z), bflo(ow[j].w), bfhi(ow[j].w)};
            const f32x4 za = {bflo(zw[j].x), bfhi(zw[j].x), bflo(zw[j].y), bfhi(zw[j].y)}, zb = {bflo(zw[j].z), bfhi(zw[j].z), bflo(zw[j].w), bfhi(zw[j].w)};
            f32x4 ra, rb;
            if (j < 2) {
                float ss = ((oa.x * oa.x + oa.y * oa.y) + (oa.z * oa.z + oa.w * oa.w)) + ((ob.x * ob.x + ob.y * ob.y) + (ob.z * ob.z + ob.w * ob.w));
#pragma unroll
                for (int s2 = 1; s2 < 16; s2 <<= 1) ss += __shfl_xor(ss, s2);
                const float rstd = rsqrtf(ss * (1.f / 128.f) + EPS);
                const f32x4 ga = *(const f32x4*)(c.gdn_norm_g + (col & 127)), gb = *(const f32x4*)(c.gdn_norm_g + (col & 127) + 4);
                ra.x = oa.x * rstd * ga.x * siluf(za.x); ra.y = oa.y * rstd * ga.y * siluf(za.y); ra.z = oa.z * rstd * ga.z * siluf(za.z); ra.w = oa.w * rstd * ga.w * siluf(za.w);
                rb.x = ob.x * rstd * gb.x * siluf(zb.x); rb.y = ob.y * rstd * gb.y * siluf(zb.y); rb.z = ob.z * rstd * gb.z * siluf(zb.z); rb.w = ob.w * rstd * gb.w * siluf(zb.w);
            } else {
                float sm = ((oa.x + oa.y) + (oa.z + oa.w)) + ((ob.x + ob.y) + (ob.z + ob.w));
#pragma unroll
                for (int s2 = 1; s2 < 32; s2 <<= 1) sm += __shfl_xor(sm, s2);
                const float mu = sm * (1.f / 256.f);
                const f32x4 da = oa - mu, db = ob - mu;
                float vs = ((da.x * da.x + da.y * da.y) + (da.z * da.z + da.w * da.w)) + ((db.x * db.x + db.y * db.y) + (db.z * db.z + db.w * db.w));
#pragma unroll
                for (int s2 = 1; s2 < 32; s2 <<= 1) vs += __shfl_xor(vs, s2);
                const float rstd = rsqrtf(vs * (1.f / 256.f) + EPS);
                const int cc = col - 1024;
                const f32x4 ga = *(const f32x4*)(c.ret_norm_g + cc), gb = *(const f32x4*)(c.ret_norm_g + cc + 4), ba = *(const f32x4*)(c.ret_norm_b + cc), bb = *(const f32x4*)(c.ret_norm_b + cc + 4);
                ra.x = (da.x * rstd * ga.x + ba.x) * siluf(za.x); ra.y = (da.y * rstd * ga.y + ba.y) * siluf(za.y); ra.z = (da.z * rstd * ga.z + ba.z) * siluf(za.z); ra.w = (da.w * rstd * ga.w + ba.w) * siluf(za.w);
                rb.x = (db.x * rstd * gb.x + bb.x) * siluf(zb.x); rb.y = (db.y * rstd * gb.y + bb.y) * siluf(zb.y); rb.z = (db.z * rstd * gb.z + bb.z) * siluf(zb.z); rb.w = (db.w * rstd * gb.w + bb.w) * siluf(zb.w);
            }
            v4u w; w.x = pk2(ra.x, ra.y); w.y = pk2(ra.z, ra.w); w.z = pk2(rb.x, rb.y); w.w = pk2(rb.z, rb.w); o8[64 * j] = w;
        }
        if (more) {
#pragma unroll
            for (int j = 0; j < 4; ++j) { ow[j] = on[j]; zw[j] = zn[j]; } }
    }
}

__device__ __forceinline__ int tokens_per_block(int G) { return (((T + G - 1) / G) + 15) & ~15; }
__device__ __forceinline__ void ph_router(const Ctx& c) {
    constexpr int RSB = 2056;
    LAS bf16* hH = (LAS bf16*)c.lds;
    LAS bf16* hL = hH + 16 * RSB;
    LAS float* part = (LAS float*)(c.lds + 2 * 16 * RSB * 2);
    LAS float* GpL = part + 2048;
    LAS float* ShL = GpL + 2048;
    LAS int* hist = (LAS int*)(ShL + 2048);
    if (c.tid < 32) hist[c.tid] = 0;
    const int TPB = tokens_per_block(c.G), base = c.bid * TPB;
    const int lane = c.lane, w = c.wave, fi = lane & 15, kq = lane >> 4, ks = w >> 1, nt = w & 1;
    if (base >= T) { __syncthreads(); if (c.tid < 32) c.blk_cnt[c.bid * 32 + c.tid] = 0; return; }
    v2u xn[2][8];
    { const int m0 = base + 2 * w; const int mr = m0 < T ? m0 : 0;
#pragma unroll
      for (int r = 0; r < 2; ++r) { const v2u* xr = (const v2u*)(c.X1 + (size_t)(mr + r) * D) + lane;
#pragma unroll
          for (int j = 0; j < 8; ++j) xn[r][j] = xr[64 * j]; } }
    const float brt = c.b_router[c.tid & 31];
    bf16x8 wrH[16], wrL[16];
    { const float* bp = c.wr_t + (size_t)(16 * nt + fi) * D + 512 * ks + 8 * kq;
#pragma unroll
      for (int s2 = 0; s2 < 16; ++s2) { const f32x4 f0 = *(const f32x4*)(bp + 32 * s2), f1 = *(const f32x4*)(bp + 32 * s2 + 4);
          const unsigned h0 = cvt2(f0.x, f0.y), h1 = cvt2(f0.z, f0.w), h2 = cvt2(f1.x, f1.y), h3 = cvt2(f1.z, f1.w);
          const unsigned l0 = cvt2(f0.x - bflo(h0), f0.y - bfhi(h0)), l1 = cvt2(f0.z - bflo(h1), f0.w - bfhi(h1)), l2 = cvt2(f1.x - bflo(h2), f1.y - bfhi(h2)), l3 = cvt2(f1.z - bflo(h3), f1.w - bfhi(h3));
          wrH[s2] = __builtin_bit_cast(bf16x8, (v4u){h0, h1, h2, h3}); wrL[s2] = __builtin_bit_cast(bf16x8, (v4u){l0, l1, l2, l3}); } }
    int cbat = -1;
    for (int p0 = 0; p0 < TPB; p0 += 16) {
        if (base + p0 >= T) break;
        const int bat = (base + p0) >> 12;
        if (bat != cbat) {
            cbat = bat; __syncthreads();
            const float* mb = c.mod + bat * MODW; const int col = 4 * c.tid;
            const f32x4 g = *(const f32x4*)(c.norm2_g + col), sc = *(const f32x4*)(mb + 4 * D + col), sh = *(const f32x4*)(mb + 3 * D + col);
            *(LAS f32x4*)(GpL + col) = g * (1.f + sc); *(LAS f32x4*)(ShL + col) = sh;
            __syncthreads();
        }
        {
            const int m0 = base + p0 + 2 * w;
            const bool ok = m0 < T;
            const int mr = ok ? m0 : 0;
#pragma unroll
            for (int r = 0; r < 2; ++r) {
                f32x4 h[8]; float ss = 0.f;
#pragma unroll
                for (int j = 0; j < 8; ++j) { h[j] = (f32x4){bflo(xn[r][j].x), bfhi(xn[r][j].x), bflo(xn[r][j].y), bfhi(xn[r][j].y)};
                    ss += (h[j].x * h[j].x + h[j].y * h[j].y) + (h[j].z * h[j].z + h[j].w * h[j].w); }
                const float rstd = rsqrtf(wave_sum(ss) * (1.f / D) + EPS);
                unsigned* o4 = (unsigned*)(c.H8 + (size_t)(mr + r) * D) + lane; const int lo = (2 * w + r) * RSB + 4 * lane;
#pragma unroll
                for (int j = 0; j < 8; ++j) { const f32x4 gp = *(const LAS f32x4*)(GpL + 4 * lane + 256 * j), sh = *(const LAS f32x4*)(ShL + 4 * lane + 256 * j);
                    const f32x4 v = (h[j] * rstd) * gp + sh;
                    if (ok) o4[64 * j] = pk4_fp8(v.x, v.y, v.z, v.w);
                    v2u hw, lw; hw.x = cvt2(v.x, v.y); hw.y = cvt2(v.z, v.w);
                    lw.x = cvt2(v.x - bflo(hw.x), v.y - bfhi(hw.x)); lw.y = cvt2(v.z - bflo(hw.y), v.w - bfhi(hw.y));
                    *(LAS v2u*)(hH + lo + 256 * j) = hw; *(LAS v2u*)(hL + lo + 256 * j) = lw; }
            }
            const int m1 = m0 + 16;
            if (p0 + 16 < TPB && m1 < T) {
#pragma unroll
                for (int r = 0; r < 2; ++r) { const v2u* xr = (const v2u*)(c.X1 + (size_t)(m1 + r) * D) + lane;
#pragma unroll
                    for (int j = 0; j < 8; ++j) xn[r][j] = xr[64 * j]; } }
        }
        __syncthreads();
        {
            f32x4 aHH = {0.f, 0.f, 0.f, 0.f}, aHL = {0.f, 0.f, 0.f, 0.f}, aLH = {0.f, 0.f, 0.f, 0.f};
            const int ao = fi * RSB + 512 * ks + 8 * kq;
#pragma unroll
            for (int s2 = 0; s2 < 16; ++s2) {
                const bf16x8 ah = *(const LAS bf16x8*)(hH + ao + 32 * s2), al = *(const LAS bf16x8*)(hL + ao + 32 * s2);
                aHH = __builtin_amdgcn_mfma_f32_16x16x32_bf16(ah, wrH[s2], aHH, 0, 0, 0); aHL = __builtin_amdgcn_mfma_f32_16x16x32_bf16(ah, wrL[s2], aHL, 0, 0, 0); aLH = __builtin_amdgcn_mfma_f32_16x16x32_bf16(al, wrH[s2], aLH, 0, 0, 0);
            }
            *(LAS f32x4*)(part + ((ks * 2 + nt) * 64 + lane) * 4) = aHH + (aHL + aLH);
        }
        __syncthreads();
        {
            const int i = c.tid >> 5, e_me = c.tid & 31, m = base + p0 + i;
            float val = brt;
            const LAS float* pp = part + (((e_me >> 4) * 64) + ((i >> 2) * 16 + (e_me & 15))) * 4 + (i & 3);
#pragma unroll
            for (int ww = 0; ww < 4; ++ww) val += pp[ww * 2 * 64 * 4];
            float selv[4]; int seli[4];
#pragma unroll
            for (int k = 0; k < 4; ++k) {
                float mx = val; int idx = e_me;
#pragma unroll
                for (int off = 16; off >= 1; off >>= 1) { const float om = __shfl_xor(mx, off); const int oi = __shfl_xor(idx, off); if (om > mx || (om == mx && oi < idx)) { mx = om; idx = oi; } }
                selv[k] = mx; seli[k] = idx; if (e_me == idx) val = -INFINITY;
            }
            const float e1 = expf(selv[1] - selv[0]), e2 = expf(selv[2] - selv[0]), e3 = expf(selv[3] - selv[0]); const float inv = 1.f / (1.f + e1 + e2 + e3);
            if (e_me == 0 && m < T) {
                c.tok_e[m * 4 + 0] = seli[0]; c.tok_e[m * 4 + 1] = seli[1]; c.tok_e[m * 4 + 2] = seli[2]; c.tok_e[m * 4 + 3] = seli[3];
                c.tok_g[m * 4 + 0] = inv; c.tok_g[m * 4 + 1] = e1 * inv; c.tok_g[m * 4 + 2] = e2 * inv; c.tok_g[m * 4 + 3] = e3 * inv;
                lds_inc(&hist[seli[0]]); lds_inc(&hist[seli[1]]); lds_inc(&hist[seli[2]]); lds_inc(&hist[seli[3]]); }
        }
    }
    __syncthreads();
    if (c.tid < 32) c.blk_cnt[c.bid * 32 + c.tid] = hist[c.tid];
}

__device__ __forceinline__ void ph_route2(const Ctx& c) {
    LAS int* part_all = (LAS int*)c.lds;
    LAS int* part_bef = part_all + 512;
    LAS int* tot = part_bef + 512;
    LAS int* bas = tot + 32;
    LAS int* pst = bas + 32;
    LAS int* ent = pst + 64;
    const int TPB = tokens_per_block(c.G), base = c.bid * TPB, nent = TPB * 4;
    LAS int* posl = ent + nent;
    { const int e = c.tid & 31, part = c.tid >> 5; int sa = 0, sb = 0;
      for (int bb = part; bb < c.G; bb += 16) { const int v = c.blk_cnt[bb * 32 + e]; sa += v; if (bb < c.bid) sb += v; }
      part_all[part * 32 + e] = sa; part_bef[part * 32 + e] = sb; }
    __syncthreads();
    if (c.tid < 32) { int sa = 0, sb = 0;
#pragma unroll
        for (int p = 0; p < 16; ++p) { sa += part_all[p * 32 + c.tid]; sb += part_bef[p * 32 + c.tid]; }
        tot[c.tid] = sa; bas[c.tid] = sb; }
    __syncthreads();
    if (c.tid == 0) { int p = 0; for (int e = 0; e < 32; ++e) { pst[e] = p; p += (tot[e] + 255) & ~255; } pst[32] = p; }
    for (int i = c.tid; i < nent; i += NTHREADS) { const int tok = base + (i >> 2); ent[i] = tok < T ? c.tok_e[tok * 4 + (i & 3)] : -1; }
    __syncthreads();
    for (int i = c.tid; i < nent; i += NTHREADS) {
        const int e = ent[i]; int pos = -1;
        if (e >= 0) { int rank = 0; for (int j = 0; j < i; ++j) rank += (ent[j] == e) ? 1 : 0;
            pos = pst[e] + bas[e] + rank; const int tok = base + (i >> 2);
            c.tok_pos[tok * 4 + (i & 3)] = pos; c.row_gate[pos] = c.tok_g[tok * 4 + (i & 3)]; c.row_tok[pos] = tok; }
        posl[i] = pos;
    }
    __syncthreads();
    for (int i0 = 4 * c.wave; i0 < nent; i0 += 4 * NWAVES) {
        v4u v[4][2]; int ps[4];
#pragma unroll
        for (int k = 0; k < 4; ++k) { const int i = i0 + k; ps[k] = (i < nent) ? posl[i] : -1; const int tok = base + (i >> 2);
            const v4u* src = (const v4u*)(c.H8 + (size_t)(ps[k] >= 0 ? tok : 0) * D) + c.lane; v[k][0] = src[0]; v[k][1] = src[64]; }
#pragma unroll
        for (int k = 0; k < 4; ++k) if (ps[k] >= 0) { v4u* dst = (v4u*)(c.XS8 + (size_t)ps[k] * D) + c.lane; dst[0] = v[k][0]; dst[64] = v[k][1]; }
    }
    if (c.bid == 0) {
        const int nmt = pst[32] >> 8;
        for (int mt = c.tid; mt < nmt; mt += NTHREADS) { int e = 0; while (e < 31 && pst[e + 1] <= mt * 256) ++e; c.tile_e[mt] = e; }
        if (c.tid == 0) c.meta[0] = nmt;
    }
}

__device__ __forceinline__ void ph_final(const Ctx& c) {
    const int gw = c.bid * NWAVES + c.wave, NGW = c.G * NWAVES;
    for (int m = gw; m < T; m += NGW) {
        const int b = m >> 12;
        const float* gt2 = c.mod + b * MODW + 5 * D;
        const v4u* xr = (const v4u*)(c.X1 + (size_t)m * D) + c.lane;
        int pos[4];
#pragma unroll
        for (int k = 0; k < 4; ++k) pos[k] = c.tok_pos[m * 4 + k];
        f32x4 v[8]; float ss = 0.f;
#pragma unroll
        for (int j = 0; j < 4; ++j) {
            const int col = 8 * c.lane + 512 * j; f32x4 y0 = {0.f, 0.f, 0.f, 0.f}, y1 = {0.f, 0.f, 0.f, 0.f};
#pragma unroll
            for (int k = 0; k < 4; ++k) { const v4u w = *((const v4u*)(c.Y + (size_t)pos[k] * D) + c.lane + 64 * j);
                y0.x += bflo(w.x); y0.y += bfhi(w.x); y0.z += bflo(w.y); y0.w += bfhi(w.y); y1.x += bflo(w.z); y1.y += bfhi(w.z); y1.z += bflo(w.w); y1.w += bfhi(w.w); }
            const f32x4 g0 = *(const f32x4*)(gt2 + col), g1 = *(const f32x4*)(gt2 + col + 4);
            const v4u xw = xr[64 * j]; const f32x4 x0 = {bflo(xw.x), bfhi(xw.x), bflo(xw.y), bfhi(xw.y)}, x1 = {bflo(xw.z), bfhi(xw.z), bflo(xw.w), bfhi(xw.w)};
            v[2 * j] = x0 + g0 * y0; v[2 * j + 1] = x1 + g1 * y1;
            ss += ((v[2 * j].x * v[2 * j].x + v[2 * j].y * v[2 * j].y) + (v[2 * j].z * v[2 * j].z + v[2 * j].w * v[2 * j].w))
                + ((v[2 * j + 1].x * v[2 * j + 1].x + v[2 * j + 1].y * v[2 * j + 1].y) + (v[2 * j + 1].z * v[2 * j + 1].z + v[2 * j + 1].w * v[2 * j + 1].w));
        }
        const float rstd = rsqrtf(wave_sum(ss) * (1.f / D) + EPS);
        float* orow = c.out + (size_t)m * D + 8 * c.lane;
#pragma unroll
        for (int j = 0; j < 4; ++j) { const f32x4 g0 = *(const f32x4*)(c.final_g + 8 * c.lane + 512 * j), g1 = *(const f32x4*)(c.final_g + 8 * c.lane + 512 * j + 4);
            *(f32x4*)(orow + 512 * j) = v[2 * j] * rstd * g0; *(f32x4*)(orow + 512 * j + 4) = v[2 * j + 1] * rstd * g1; }
    }
}

struct ARowDense { const bf16* A; __device__ __forceinline__ const bf16* operator()(int row) const { return A + (size_t)row * D; } };
struct BRowDense { const bf16* Bt; __device__ __forceinline__ const bf16* operator()(int, int n) const { return Bt + (size_t)n * D; } };
struct BRowExpert { const bf16* Bt; const int* tile_e; int N; __device__ __forceinline__ const bf16* operator()(int mt64, int n) const { return Bt + ((size_t)tile_e[mt64 >> 2] * N + n) * D; } };
struct NEpiProj { bf16* O; __device__ __forceinline__ void operator()(int row, int cb, int tx, const float (&v)[8]) const {
#pragma unroll
        for (int i = 0; i < 8; ++i) O[(size_t)row * NPROJ + cb + tx + 32 * i] = (bf16)f2bf(v[i]); } };
struct NEpiResid { const float* x; const float* mod; bf16* X1; __device__ __forceinline__ void operator()(int row, int cb, int tx, const float (&v)[8]) const {
        const float* gt1 = mod + (row >> 12) * MODW + 2 * D;
#pragma unroll
        for (int i = 0; i < 8; ++i) { const int n = cb + tx + 32 * i; X1[(size_t)row * D + n] = (bf16)f2bf(x[(size_t)row * D + n] + gt1[n] * v[i]); } } };
__device__ __forceinline__ float swiglu(float g, float l) { g = fminf(g, 7.f); l = __builtin_amdgcn_fmed3f(l, -7.f, 7.f); return (g * __builtin_amdgcn_rcpf(1.f + __builtin_amdgcn_exp2f(-2.4554669595930156f * g))) * (l + 1.f); }
struct NEpiUp { bf16* ACT; const float* b1; const int* tile_e; __device__ __forceinline__ void operator()(int row, int cb, int tx, const float (&v)[8]) const {
        const int e = tile_e[row >> 8];
#pragma unroll
        for (int i = 0; i < 4; ++i) { const int f = (cb >> 8) * 128 + tx + 32 * i; const float g = v[i] + b1[e * 4096 + f], l = v[i + 4] + b1[e * 4096 + 2048 + f]; ACT[(size_t)row * D + f] = (bf16)f2bf(swiglu(g, l)); } } };
struct NEpiDown { bf16* Y; const float* b2; const int* tile_e; const float* row_gate; __device__ __forceinline__ void operator()(int row, int cb, int tx, const float (&v)[8]) const {
        const int e = tile_e[row >> 8]; const float gt = row_gate[row];
#pragma unroll
        for (int i = 0; i < 8; ++i) { const int n = cb + tx + 32 * i; Y[(size_t)row * D + n] = (bf16)f2bf((v[i] + b2[e * D + n]) * gt); } } };

namespace pg8 {
constexpr int BM = 256, BK = 64, HALF = 128, HTB = HALF * BK * 2, STAGE_BYTES = 8 * HTB, NXCD = 8, WGM = 8;
constexpr int K = D;
__host__ __device__ __forceinline__ int lds_byte(int r, int c) { const int st = (r >> 4) * 2 + (c >> 5), rr = r & 15, cc = c & 31, ob = rr * 64 + cc * 2; return st * 1024 + (ob ^ (((ob >> 9) & 1) << 5)); }
__host__ __device__ __forceinline__ void stage_rc(int b, int& R, int& C) { const int st = b / 1024, sb = b % 1024, swz = sb ^ (((sb >> 9) & 1) << 5); R = (st >> 1) * 16 + swz / 64; C = (st & 1) * 32 + (swz % 64) / 2; }
__host__ __device__ __forceinline__ int perm32(int rho) { const int n = rho >> 4, i = rho & 15; return 8 * (i >> 2) + 4 * n + (i & 3); }
struct Unit { int pm, pn; };
struct Sched {
    const void* A; const void* Bt; const int* tile_e; int N; int nM, nN, nwg, G, c; size_t rb;
    __device__ void init(const void* A_, const void* Bt_, const int* te, int nM_, int N_, int G_, int c_, size_t rb_) { A = A_; Bt = Bt_; tile_e = te; N = N_; nM = nM_; nN = N_ / BM; nwg = nM * nN; G = G_; c = c_; rb = rb_; }
    __device__ __forceinline__ bool next(int i, Unit& u) const {
        const long L = (long)i * G + c; if (L >= nwg) return false;
        int wgid = (int)L; { const int q = nwg / NXCD, r = nwg % NXCD, xcd = wgid % NXCD, off = wgid / NXCD; wgid = (xcd < r ? xcd * (q + 1) : r * (q + 1) + (xcd - r) * q) + off; }
        const int nig = WGM * nN, gid = wgid / nig, fm = gid * WGM, gsz = (nM - fm) < WGM ? (nM - fm) : WGM;
        u.pm = fm + ((wgid % nig) % gsz); u.pn = (wgid % nig) / gsz; return true;
    }
    __device__ __forceinline__ const char* a_base(const Unit& u) const { return (const char*)A + (size_t)u.pm * ((size_t)BM * rb); }
    __device__ __forceinline__ const char* b_base(const Unit& u) const { const size_t e = tile_e ? (size_t)__builtin_amdgcn_readfirstlane(tile_e[u.pm]) : 0; return (const char*)Bt + (e * N + (size_t)u.pn * BM) * rb; }
};
__device__ __forceinline__ unsigned cvt_pk_bf16(float lo, float hi) { unsigned r; asm volatile("v_cvt_pk_bf16_f32 %0, %1, %2" : "=v"(r) : "v"(lo), "v"(hi)); return r; }
struct EpiProj {
    static constexpr bool PERM = true;
    bf16* O; int ldc;
    __device__ __forceinline__ void operator()(const f32x4 (&acc)[2][2][4][2], const Unit& u, int wr, int wc, int fr, int fq) const {
        const int row0 = u.pm * BM + wr * 64 + fr, col0 = u.pn * BM + wc * 32 + 8 * fq;
#pragma unroll
        for (int ai = 0; ai < 2; ++ai)
#pragma unroll
            for (int m = 0; m < 4; ++m) { bf16* rowp = O + (size_t)(row0 + ai * HALF + m * 16) * ldc + col0;
#pragma unroll
                for (int bj = 0; bj < 2; ++bj) { const f32x4 v0 = acc[ai][bj][m][0], v1 = acc[ai][bj][m][1];
                    v4u w; w.x = cvt_pk_bf16(v0[0], v0[1]); w.y = cvt_pk_bf16(v0[2], v0[3]); w.z = cvt_pk_bf16(v1[0], v1[1]); w.w = cvt_pk_bf16(v1[2], v1[3]);
                    *(v4u*)(rowp + bj * HALF) = w; } }
    }
};
struct EpiResid {
    static constexpr bool PERM = true;
    const float* x; const float* mod; bf16* X1;
    __device__ __forceinline__ void operator()(const f32x4 (&acc)[2][2][4][2], const Unit& u, int wr, int wc, int fr, int fq) const {
        const int row0 = u.pm * BM + wr * 64 + fr, col0 = u.pn * BM + wc * 32 + 8 * fq;
        const float* gt = mod + (u.pm >> 4) * MODW + 2 * D + col0;
        f32x4 gv[2][2];
#pragma unroll
        for (int bj = 0; bj < 2; ++bj)
#pragma unroll
            for (int n = 0; n < 2; ++n) gv[bj][n] = *(const f32x4*)(gt + bj * HALF + n * 4);
#pragma unroll
        for (int ai = 0; ai < 2; ++ai)
#pragma unroll
            for (int m = 0; m < 4; ++m) { const size_t off = (size_t)(row0 + ai * HALF + m * 16) * D + col0;
#pragma unroll
                for (int bj = 0; bj < 2; ++bj) { const f32x4 x0 = *(const f32x4*)(x + off + bj * HALF), x1 = *(const f32x4*)(x + off + bj * HALF + 4);
                    const f32x4 r0 = x0 + gv[bj][0] * acc[ai][bj][m][0], r1 = x1 + gv[bj][1] * acc[ai][bj][m][1];
                    v4u w; w.x = cvt2(r0[0], r0[1]); w.y = cvt2(r0[2], r0[3]); w.z = cvt2(r1[0], r1[1]); w.w = cvt2(r1[2], r1[3]);
                    *(v4u*)(X1 + off + bj * HALF) = w; }
                if (m == 3) asm volatile("" ::: "memory"); }
    }
};
struct EpiUp {
    static constexpr bool PERM = true;
    bf16* ACT; const float* b1; const int* tile_e;
    __device__ __forceinline__ void operator()(const f32x4 (&acc)[2][2][4][2], const Unit& u, int wr, int wc, int fr, int fq) const {
        const int e = tile_e[u.pm];
        const int row0 = u.pm * BM + wr * 64 + fr, f0 = u.pn * 128 + wc * 32 + 8 * fq;
        f32x4 bg[2], bl[2];
#pragma unroll
        for (int n = 0; n < 2; ++n) { bg[n] = *(const f32x4*)(b1 + (size_t)e * 4096 + f0 + 4 * n); bl[n] = *(const f32x4*)(b1 + (size_t)e * 4096 + 2048 + f0 + 4 * n); }
#pragma unroll
        for (int ai = 0; ai < 2; ++ai)
#pragma unroll
            for (int m = 0; m < 4; ++m) { bf16* rowp = ACT + (size_t)(row0 + ai * HALF + m * 16) * D + f0;
                f32x4 a[2];
#pragma unroll
                for (int n = 0; n < 2; ++n) { const f32x4 g = acc[ai][0][m][n] + bg[n], l = acc[ai][1][m][n] + bl[n];
                    a[n][0] = swiglu(g[0], l[0]); a[n][1] = swiglu(g[1], l[1]); a[n][2] = swiglu(g[2], l[2]); a[n][3] = swiglu(g[3], l[3]); }
                v4u w; w.x = cvt_pk_bf16(a[0][0], a[0][1]); w.y = cvt_pk_bf16(a[0][2], a[0][3]); w.z = cvt_pk_bf16(a[1][0], a[1][1]); w.w = cvt_pk_bf16(a[1][2], a[1][3]);
                *(v4u*)rowp = w; }
    }
};
struct EpiDown {
    static constexpr bool PERM = true;
    bf16* Y; const float* b2; const int* tile_e; const float* row_gate;
    __device__ __forceinline__ void operator()(const f32x4 (&acc)[2][2][4][2], const Unit& u, int wr, int wc, int fr, int fq) const {
        const int e = tile_e[u.pm];
        const int row0 = u.pm * BM + wr * 64 + fr, col0 = u.pn * BM + wc * 32 + 8 * fq;
        f32x4 bv[2][2];
#pragma unroll
        for (int bj = 0; bj < 2; ++bj)
#pragma unroll
            for (int n = 0; n < 2; ++n) bv[bj][n] = *(const f32x4*)(b2 + (size_t)e * D + col0 + bj * HALF + 4 * n);
#pragma unroll
        for (int ai = 0; ai < 2; ++ai)
#pragma unroll
            for (int m = 0; m < 4; ++m) { const int row = row0 + ai * HALF + m * 16; const float gt = row_gate[row]; bf16* rowp = Y + (size_t)row * D + col0;
#pragma unroll
                for (int bj = 0; bj < 2; ++bj) { const f32x4 v0 = (acc[ai][bj][m][0] + bv[bj][0]) * gt, v1 = (acc[ai][bj][m][1] + bv[bj][1]) * gt;
                    v4u w; w.x = cvt_pk_bf16(v0[0], v0[1]); w.y = cvt_pk_bf16(v0[2], v0[3]); w.z = cvt_pk_bf16(v1[0], v1[1]); w.w = cvt_pk_bf16(v1[2], v1[3]);
                    *(v4u*)(rowp + bj * HALF) = w; } }
    }
};

struct EpiUpF8 {
    static constexpr bool PERM = true;
    unsigned char* ACT; const float* b1; const int* tile_e;
    __device__ __forceinline__ void operator()(const f32x4 (&acc)[2][2][4][2], const Unit& u, int wr, int wc, int fr, int fq) const {
        const int e = tile_e[u.pm];
        const int row0 = u.pm * BM + wr * 64 + fr, f0 = u.pn * 128 + wc * 32 + 8 * fq;
        f32x4 bg[2], bl[2];
#pragma unroll
        for (int n = 0; n < 2; ++n) { bg[n] = *(const f32x4*)(b1 + (size_t)e * 4096 + f0 + 4 * n); bl[n] = *(const f32x4*)(b1 + (size_t)e * 4096 + 2048 + f0 + 4 * n); }
#pragma unroll
        for (int ai = 0; ai < 2; ++ai)
#pragma unroll
            for (int m = 0; m < 4; ++m) { unsigned char* rowp = ACT + (size_t)(row0 + ai * HALF + m * 16) * D + f0;
                v2u w;
#pragma unroll
                for (int n = 0; n < 2; ++n) { const f32x4 g = acc[ai][0][m][n] + bg[n], l = acc[ai][1][m][n] + bl[n];
                    const unsigned p = pk4_fp8_nc(swiglu(g[0], l[0]), swiglu(g[1], l[1]), swiglu(g[2], l[2]), swiglu(g[3], l[3])); if (n == 0) w.x = p; else w.y = p; }
                *(v2u*)rowp = w; }
    }
};
typedef int v8i __attribute__((ext_vector_type(8)));
template <class Epi>
__device__ __forceinline__ void gemm_phase_f8(LAS unsigned char* lds, const Sched& S, const Epi& E) {
    const int tid = threadIdx.x, wid = __builtin_amdgcn_readfirstlane(tid >> 6), lane = tid & 63, wr = wid >> 2, wc = wid & 3, fr = lane & 15, fq = lane >> 4;
    constexpr int KB = K;
    constexpr int nt = KB / 128;
    unsigned voffA[2], voffB[2];
#pragma unroll
    for (int i = 0; i < 2; ++i) { int R, C; stage_rc(tid * 16 + i * 8192, R, C); const int Rb = Epi::PERM ? ((R & ~31) + perm32(R & 31)) : R;
        voffA[i] = (unsigned)(R * KB + 2 * C); voffB[i] = (unsigned)(Rb * KB + 2 * C); }
    constexpr size_t kstep = 128;
    constexpr size_t hstep = (size_t)HALF * KB;
    const unsigned ldsw = (unsigned)wid * 1024u;
    const int aoff = lds_byte(wr * 64 + fr, fq * 16), boff = lds_byte(wc * 32 + fr, fq * 16);
#define PG8_SA(b, h) (((b) * 2 + (h)) * HTB)
#define PG8_SB(b, h) ((4 + (b) * 2 + (h)) * HTB)
#define PG8_STAGE(bufoff, gbase, voff) do { _Pragma("unroll") for (int _i = 0; _i < 2; ++_i) \
        __builtin_amdgcn_global_load_lds((const unsigned*)((const char*)(gbase) + (voff)[_i]), (LAS unsigned*)(lds + (bufoff) + ldsw + _i * 8192), 16, 0, 0); } while (0)
#define PG8_LD8(dst, off) do { const v4u _x = *(const LAS v4u*)(lds + (off)), _y = *(const LAS v4u*)(lds + (off) + 16); \
        dst = (v8i){(int)_x.x, (int)_x.y, (int)_x.z, (int)_x.w, (int)_y.x, (int)_y.y, (int)_y.z, (int)_y.w}; } while (0)
#define PG8_LDA(dst, b, h) do { _Pragma("unroll") for (int m = 0; m < 4; ++m) PG8_LD8(dst[m], PG8_SA(b, h) + aoff + m * 2048); } while (0)
#define PG8_LDB(dst, b, h) do { _Pragma("unroll") for (int n = 0; n < 2; ++n) PG8_LD8(dst[n], PG8_SB(b, h) + boff + n * 2048); } while (0)
#define PG8_MMA(ai, bj, At, Bt) do { __builtin_amdgcn_s_setprio(1); _Pragma("unroll") for (int m = 0; m < 4; ++m) _Pragma("unroll") for (int n = 0; n < 2; ++n) \
        asm volatile("v_mfma_scale_f32_16x16x128_f8f6f4 %0, %1, %2, %0, %3, %3 op_sel:[1,0,0] op_sel_hi:[0,0,0]" : "+v"(acc[ai][bj][m][n]) : "v"(Bt[n]), "v"(At[m]), "v"(sclv)); __builtin_amdgcn_s_setprio(0); } while (0)
#define PG8_WAIT_V(n) asm volatile("s_waitcnt vmcnt(" #n ")" ::: "memory")
#define PG8_WAIT_L(n) asm volatile("s_waitcnt lgkmcnt(" #n ")" ::: "memory")
#define PG8_BAR __builtin_amdgcn_s_barrier()
#define PG8_SCHED __builtin_amdgcn_sched_barrier(0)
    Unit cur, nxt; int ui = 0;
    if (!S.next(0, cur)) return;
    f32x4 acc[2][2][4][2];
#pragma unroll
    for (int a = 0; a < 2; ++a)
#pragma unroll
        for (int b = 0; b < 2; ++b)
#pragma unroll
            for (int m = 0; m < 4; ++m)
#pragma unroll
                for (int n = 0; n < 2; ++n) acc[a][b][m][n] = (f32x4){0.f, 0.f, 0.f, 0.f};
    v8i At[4], B0[2], B1[2];
    const int sclv = 0x0000777F;
    const char* cA = S.a_base(cur); const char* cB = S.b_base(cur);
    PG8_STAGE(PG8_SB(0, 0), cB, voffB); PG8_STAGE(PG8_SB(0, 1), cB + hstep, voffB); PG8_STAGE(PG8_SA(0, 0), cA, voffA); PG8_STAGE(PG8_SA(0, 1), cA + hstep, voffA);
    if (wr == 1) PG8_BAR;
    PG8_WAIT_V(2); PG8_BAR;
    PG8_STAGE(PG8_SB(1, 0), cB + kstep, voffB); PG8_STAGE(PG8_SA(1, 0), cA + kstep, voffA); PG8_STAGE(PG8_SB(1, 1), cB + hstep + kstep, voffB);
    PG8_WAIT_V(6); PG8_BAR;
    for (;;) {
        const bool has_next = S.next(ui + 1, nxt);
        const char* nA = has_next ? S.a_base(nxt) : cA; const char* nB = has_next ? S.b_base(nxt) : cB;
        for (int t = 0; t < nt; t += 2) {
            const bool last = (t == nt - 2);
            const char* a1 = cA + (size_t)(t + 1) * kstep;
            const char* a2 = last ? nA : cA + (size_t)(t + 2) * kstep; const char* b2 = last ? nB : cB + (size_t)(t + 2) * kstep;
            const char* a3 = a2 + kstep; const char* b3 = b2 + kstep;
            PG8_LDB(B0, 0, 0); PG8_LDB(B1, 0, 1); PG8_SCHED; PG8_LDA(At, 0, 0); PG8_STAGE(PG8_SA(1, 1), a1 + hstep, voffA);
            PG8_WAIT_V(8); PG8_WAIT_L(0); PG8_BAR; PG8_MMA(0, 0, At, B0); PG8_MMA(0, 1, At, B1); PG8_BAR; PG8_SCHED;
            PG8_LDA(At, 0, 1); PG8_STAGE(PG8_SB(0, 0), b2, voffB); PG8_STAGE(PG8_SB(0, 1), b2 + hstep, voffB); PG8_STAGE(PG8_SA(0, 0), a2, voffA);
            PG8_WAIT_V(8); PG8_WAIT_L(0); PG8_BAR; PG8_MMA(1, 0, At, B0); PG8_MMA(1, 1, At, B1); PG8_BAR; PG8_SCHED;
            PG8_LDB(B0, 1, 0); PG8_LDB(B1, 1, 1); PG8_SCHED; PG8_LDA(At, 1, 0); PG8_STAGE(PG8_SA(0, 1), a2 + hstep, voffA);
            PG8_WAIT_V(8); PG8_WAIT_L(0); PG8_BAR; PG8_MMA(0, 0, At, B0); PG8_MMA(0, 1, At, B1); PG8_BAR; PG8_SCHED;
            PG8_LDA(At, 1, 1); PG8_STAGE(PG8_SB(1, 0), b3, voffB); PG8_STAGE(PG8_SB(1, 1), b3 + hstep, voffB); PG8_STAGE(PG8_SA(1, 0), a3, voffA);
            PG8_WAIT_V(8); PG8_WAIT_L(0); PG8_BAR; PG8_MMA(1, 0, At, B0); PG8_MMA(1, 1, At, B1); PG8_BAR; PG8_SCHED;
        }
        if (wr == 0) PG8_BAR;
        asm volatile("s_nop 15\n\ts_nop 15" ::: "memory");
        E(acc, cur, wr, wc, fr, fq);
        if (!has_next) break;
#pragma unroll
        for (int a = 0; a < 2; ++a)
#pragma unroll
            for (int b = 0; b < 2; ++b)
#pragma unroll
                for (int m = 0; m < 4; ++m)
#pragma unroll
                    for (int n = 0; n < 2; ++n) acc[a][b][m][n] = (f32x4){0.f, 0.f, 0.f, 0.f};
        asm volatile("s_nop 7" ::: "memory");
        cur = nxt; cA = nA; cB = nB; ++ui;
        if (wr == 1) PG8_BAR;
    }
    PG8_WAIT_V(0);
    PG8_BAR;
#undef PG8_SA
#undef PG8_SB
#undef PG8_STAGE
#undef PG8_LD8
#undef PG8_LDA
#undef PG8_LDB
#undef PG8_MMA
#undef PG8_WAIT_V
#undef PG8_WAIT_L
#undef PG8_BAR
#undef PG8_SCHED
}

template <class Epi>
__device__ __forceinline__ void gemm_phase(LAS unsigned char* lds, const Sched& S, const Epi& E) {
    const int tid = threadIdx.x, wid = __builtin_amdgcn_readfirstlane(tid >> 6), lane = tid & 63, wr = wid >> 2, wc = wid & 3, fr = lane & 15, fq = lane >> 4;
    constexpr int nt = K / BK;
    unsigned voffA[2], voffB[2];
#pragma unroll
    for (int i = 0; i < 2; ++i) { int R, C; stage_rc(tid * 16 + i * 8192, R, C); const int Rb = Epi::PERM ? ((R & ~31) + perm32(R & 31)) : R;
        voffA[i] = (unsigned)(R * K + C) * 2u; voffB[i] = (unsigned)(Rb * K + C) * 2u; }
    constexpr size_t kstep = (size_t)(BK * 2);
    constexpr size_t hstep = (size_t)HALF * K * 2;
    const unsigned ldsw = (unsigned)wid * 1024u;
    const int aoff = lds_byte(wr * 64 + fr, fq * 8), boff = lds_byte(wc * 32 + fr, fq * 8);
#define PG8_SA(b, h) (((b) * 2 + (h)) * HTB)
#define PG8_SB(b, h) ((4 + (b) * 2 + (h)) * HTB)
#define PG8_STAGE(bufoff, gbase, voff) do { _Pragma("unroll") for (int _i = 0; _i < 2; ++_i) \
        __builtin_amdgcn_global_load_lds((const unsigned*)((const char*)(gbase) + (voff)[_i]), (LAS unsigned*)(lds + (bufoff) + ldsw + _i * 8192), 16, 0, 0); } while (0)
#define PG8_LDA(dst, b, h) do { _Pragma("unroll") for (int m = 0; m < 4; ++m) _Pragma("unroll") for (int k = 0; k < 2; ++k) dst[m][k] = *(const LAS bf16x8*)(lds + PG8_SA(b, h) + aoff + m * 2048 + k * 1024); } while (0)
#define PG8_LDB(dst, b, h) do { _Pragma("unroll") for (int n = 0; n < 2; ++n) _Pragma("unroll") for (int k = 0; k < 2; ++k) dst[n][k] = *(const LAS bf16x8*)(lds + PG8_SB(b, h) + boff + n * 2048 + k * 1024); } while (0)
#define PG8_MMA(ai, bj, At, Bt) do { __builtin_amdgcn_s_setprio(1); _Pragma("unroll") for (int m = 0; m < 4; ++m) _Pragma("unroll") for (int n = 0; n < 2; ++n) _Pragma("unroll") for (int k = 0; k < 2; ++k) \
        acc[ai][bj][m][n] = __builtin_amdgcn_mfma_f32_16x16x32_bf16(Bt[n][k], At[m][k], acc[ai][bj][m][n], 0, 0, 0); __builtin_amdgcn_s_setprio(0); } while (0)
#define PG8_WAIT_V(n) asm volatile("s_waitcnt vmcnt(" #n ")" ::: "memory")
#define PG8_WAIT_L(n) asm volatile("s_waitcnt lgkmcnt(" #n ")" ::: "memory")
#define PG8_BAR __builtin_amdgcn_s_barrier()
#define PG8_SCHED __builtin_amdgcn_sched_barrier(0)
    Unit cur, nxt; int ui = 0;
    if (!S.next(0, cur)) return;
    f32x4 acc[2][2][4][2];
#pragma unroll
    for (int a = 0; a < 2; ++a)
#pragma unroll
        for (int b = 0; b < 2; ++b)
#pragma unroll
            for (int m = 0; m < 4; ++m)
#pragma unroll
                for (int n = 0; n < 2; ++n) acc[a][b][m][n] = (f32x4){0.f, 0.f, 0.f, 0.f};
    bf16x8 At[4][2], B0[2][2], B1[2][2];
    const char* cA = S.a_base(cur); const char* cB = S.b_base(cur);
    PG8_STAGE(PG8_SB(0, 0), cB, voffB); PG8_STAGE(PG8_SB(0, 1), cB + hstep, voffB); PG8_STAGE(PG8_SA(0, 0), cA, voffA); PG8_STAGE(PG8_SA(0, 1), cA + hstep, voffA);
    if (wr == 1) PG8_BAR;
    PG8_WAIT_V(2); PG8_BAR;
    PG8_STAGE(PG8_SB(1, 0), cB + kstep, voffB); PG8_STAGE(PG8_SA(1, 0), cA + kstep, voffA); PG8_STAGE(PG8_SB(1, 1), cB + hstep + kstep, voffB);
    PG8_WAIT_V(6); PG8_BAR;
    for (;;) {
        const bool has_next = S.next(ui + 1, nxt);
        const char* nA = has_next ? S.a_base(nxt) : cA; const char* nB = has_next ? S.b_base(nxt) : cB;
        for (int t = 0; t < nt; t += 2) {
            const bool last = (t == nt - 2);
            const char* a1 = cA + (size_t)(t + 1) * kstep;
            const char* a2 = last ? nA : cA + (size_t)(t + 2) * kstep; const char* b2 = last ? nB : cB + (size_t)(t + 2) * kstep;
            const char* a3 = a2 + kstep; const char* b3 = b2 + kstep;
            PG8_LDB(B0, 0, 0); PG8_LDB(B1, 0, 1); PG8_SCHED; PG8_LDA(At, 0, 0); PG8_STAGE(PG8_SA(1, 1), a1 + hstep, voffA);
            PG8_WAIT_V(8); PG8_WAIT_L(0); PG8_BAR; PG8_MMA(0, 0, At, B0); PG8_MMA(0, 1, At, B1); PG8_BAR; PG8_SCHED;
            PG8_LDA(At, 0, 1); PG8_STAGE(PG8_SB(0, 0), b2, voffB); PG8_STAGE(PG8_SB(0, 1), b2 + hstep, voffB); PG8_STAGE(PG8_SA(0, 0), a2, voffA);
            PG8_WAIT_V(8); PG8_WAIT_L(0); PG8_BAR; PG8_MMA(1, 0, At, B0); PG8_MMA(1, 1, At, B1); PG8_BAR; PG8_SCHED;
            PG8_LDB(B0, 1, 0); PG8_LDB(B1, 1, 1); PG8_SCHED; PG8_LDA(At, 1, 0); PG8_STAGE(PG8_SA(0, 1), a2 + hstep, voffA);
            PG8_WAIT_V(8); PG8_WAIT_L(0); PG8_BAR; PG8_MMA(0, 0, At, B0); PG8_MMA(0, 1, At, B1); PG8_BAR; PG8_SCHED;
            PG8_LDA(At, 1, 1); PG8_STAGE(PG8_SB(1, 0), b3, voffB); PG8_STAGE(PG8_SB(1, 1), b3 + hstep, voffB); PG8_STAGE(PG8_SA(1, 0), a3, voffA);
            PG8_WAIT_V(8); PG8_WAIT_L(0); PG8_BAR; PG8_MMA(1, 0, At, B0); PG8_MMA(1, 1, At, B1); PG8_BAR; PG8_SCHED;
        }
        if (wr == 0) PG8_BAR;
        E(acc, cur, wr, wc, fr, fq);
        if (!has_next) break;
#pragma unroll
        for (int a = 0; a < 2; ++a)
#pragma unroll
            for (int b = 0; b < 2; ++b)
#pragma unroll
                for (int m = 0; m < 4; ++m)
#pragma unroll
                    for (int n = 0; n < 2; ++n) acc[a][b][m][n] = (f32x4){0.f, 0.f, 0.f, 0.f};
        cur = nxt; cA = nA; cB = nB; ++ui;
        if (wr == 1) PG8_BAR;
    }
    PG8_WAIT_V(0);
    PG8_BAR;
#undef PG8_SA
#undef PG8_SB
#undef PG8_STAGE
#undef PG8_LDA
#undef PG8_LDB
#undef PG8_MMA
#undef PG8_WAIT_V
#undef PG8_WAIT_L
#undef PG8_BAR
#undef PG8_SCHED
}
}

#define MFMA16(a, b, cc) __builtin_amdgcn_mfma_f32_16x16x32_bf16(a, b, cc, 0, 0, 0)
__device__ __forceinline__ bf16x8 pack8(const f32x4 lo, const f32x4 hi) {
    v4u w; w.x = cvt2(lo[0], lo[1]); w.y = cvt2(lo[2], lo[3]); w.z = cvt2(hi[0], hi[1]); w.w = cvt2(hi[2], hi[3]);
    return __builtin_bit_cast(bf16x8, w);
}
__device__ __forceinline__ bf16x8 ld2x8(const LAS bf16* p0, const LAS bf16* p1) {
    const v2u a = *(const LAS v2u*)p0, b = *(const LAS v2u*)p1; v4u w; w.x = a.x; w.y = a.y; w.z = b.x; w.w = b.y; return __builtin_bit_cast(bf16x8, w);
}
#define TP(r) ((((r) & 7) * 17) + ((r) >> 3))
struct GdnLds { LAS float *sb, *sg; LAS bf16 *Qn, *Kn, *Vt, *Kt; LAS float* Lm; LAS bf16* Tm; };
__device__ __forceinline__ void gdn_conv_compute(const Ctx& c, int ug, v4u (&rows)[8], v4u (&cols)[8], float& beta_o, float& g_o) {
    const int n = ug & 63, h = (ug >> 6) & 7, b = ug >> 9, t0 = n * 64; const size_t rowbase = (size_t)b * SEQ;
    const int lane = c.lane, w = c.wave;
    const int cg = c.tid & 15, oct = (c.tid >> 4) & 7, mat = w >> 1;
    const int col = mat * 1024 + h * 128 + 8 * cg;
    v4u rr[11];
#pragma unroll
    for (int i = 0; i < 11; ++i) { const int tt = t0 + 8 * oct - 3 + i; const v4u ld = *(const v4u*)(c.PROJ + (rowbase + (tt < 0 ? 0 : tt)) * NPROJ + col); const unsigned msk = tt < 0 ? 0u : 0xffffffffu; rr[i] = (v4u){ld.x & msk, ld.y & msk, ld.z & msk, ld.w & msk}; }
    f32x4 cw[4][2];
#pragma unroll
    for (int i = 0; i < 4; ++i) { cw[i][0] = *(const f32x4*)(c.conv_w + i * 3072 + col); cw[i][1] = *(const f32x4*)(c.conv_w + i * 3072 + col + 4); }
    if (w == 0) {
        const size_t row = rowbase + t0 + lane;
        beta_o = sigmoidf_(c.ba[row * 16 + h]);
        float gs = -expf(c.a_log[h]) * softplusf_(c.ba[row * 16 + 8 + h] + c.dt_bias[h]);
#pragma unroll
        for (int o = 1; o < 64; o <<= 1) { const float t = __shfl_up(gs, o); if (lane >= o) gs += t; }
        g_o = gs;
    }
#pragma unroll
    for (int tp = 0; tp < 4; ++tp) {
        float y[2][8];
#pragma unroll
        for (int hh = 0; hh < 2; ++hh) { const int tk = 2 * tp + hh;
#pragma unroll
            for (int e = 0; e < 8; ++e) y[hh][e] = 0.f;
#pragma unroll
            for (int i = 0; i < 4; ++i) { const v4u ru = rr[tk + i]; const f32x4 u0 = {bflo(ru.x), bfhi(ru.x), bflo(ru.y), bfhi(ru.y)}, u1 = {bflo(ru.z), bfhi(ru.z), bflo(ru.w), bfhi(ru.w)};
                y[hh][0] += cw[i][0].x * u0.x; y[hh][1] += cw[i][0].y * u0.y; y[hh][2] += cw[i][0].z * u0.z; y[hh][3] += cw[i][0].w * u0.w;
                y[hh][4] += cw[i][1].x * u1.x; y[hh][5] += cw[i][1].y * u1.y; y[hh][6] += cw[i][1].z * u1.z; y[hh][7] += cw[i][1].w * u1.w; }
#pragma unroll
            for (int e = 0; e < 8; ++e) y[hh][e] = siluf(y[hh][e]);
            if (mat < 2) {
                float ss = 0.f;
#pragma unroll
                for (int e = 0; e < 8; ++e) ss += y[hh][e] * y[hh][e];
                ss += __shfl_xor(ss, 1); ss += __shfl_xor(ss, 2); ss += __shfl_xor(ss, 4); ss += __shfl_xor(ss, 8);
                const float rs = rsqrtf(ss + EPS) * (mat == 0 ? 0.08838834764831845f : 1.f);
#pragma unroll
                for (int e = 0; e < 8; ++e) y[hh][e] *= rs;
                v4u pw; pw.x = pk2(y[hh][0], y[hh][1]); pw.y = pk2(y[hh][2], y[hh][3]); pw.z = pk2(y[hh][4], y[hh][5]); pw.w = pk2(y[hh][6], y[hh][7]);
                rows[tk] = pw;
            }
        }
        if (mat >= 1) {
#pragma unroll
            for (int e = 0; e < 8; ++e) { const unsigned wd = pk2(y[0][e], y[1][e]); if (tp == 0) cols[e].x = wd; else if (tp == 1) cols[e].y = wd; else if (tp == 2) cols[e].z = wd; else cols[e].w = wd; } }
    }
}
__device__ __forceinline__ void gdn_conv_write(const Ctx& c, int ug, const GdnLds& P, const v4u (&rows)[8], const v4u (&cols)[8], float beta, float g) {
    const int w = c.wave, cg = c.tid & 15, oct = (c.tid >> 4) & 7, mat = w >> 1;
    if (mat < 2) {
#pragma unroll
        for (int tk = 0; tk < 8; ++tk) *(LAS v4u*)((mat == 0 ? P.Qn : P.Kn) + (8 * oct + tk) * 136 + 8 * cg) = rows[tk]; }
    if (mat >= 1) { LAS bf16* dt = (mat == 1 ? P.Kt : P.Vt);
#pragma unroll
        for (int e = 0; e < 8; ++e) *(LAS v4u*)(dt + TP(8 * cg + e) * 72 + 8 * oct) = cols[e]; }
    if (w == 0) { P.sb[c.lane] = beta; P.sg[c.lane] = g; if (c.lane == 63) c.gcd[ug] = expf(g); }
}
__device__ __forceinline__ void gdn_step2(const Ctx& c, int ug, const GdnLds& P) {
    const int lane = c.lane, q = lane >> 4, r = lane & 15, w = c.wave;
    unsigned char* img = c.gimg + (size_t)ug * GIMG_BYTES;
    LAS bf16* Qn = P.Qn; LAS bf16* Kn = P.Kn; LAS float* sb = P.sb; LAS float* sg = P.sg; LAS float* Lm = P.Lm;
#pragma unroll
    for (int tt = 0; tt < 2; ++tt) { const int tile = 2 * w + tt, ib = tile >> 2, jb = tile & 3;
        f32x4 acc = {0.f, 0.f, 0.f, 0.f};
#pragma unroll
        for (int s = 0; s < 4; ++s) { const bf16x8 a = *(const LAS bf16x8*)(Kn + (16 * ib + r) * 136 + 32 * s + 8 * q), bb = *(const LAS bf16x8*)(Kn + (16 * jb + r) * 136 + 32 * s + 8 * q); acc = MFMA16(a, bb, acc); }
        const int j = 16 * jb + r; const float gj = sg[j];
#pragma unroll
        for (int d = 0; d < 4; ++d) { const int i = 16 * ib + 4 * q + d; Lm[i * 68 + j] = (j < i) ? sb[i] * acc[d] * __expf(sg[i] - gj) : 0.f; } }
    { const int ib = w >> 1, s2 = w & 1;
        f32x4 a0 = {0.f, 0.f, 0.f, 0.f}, a1 = {0.f, 0.f, 0.f, 0.f};
#pragma unroll
        for (int s = 0; s < 4; ++s) { const bf16x8 bq = *(const LAS bf16x8*)(Qn + (16 * ib + r) * 136 + 32 * s + 8 * q);
            const bf16x8 k0 = *(const LAS bf16x8*)(Kn + (32 * s2 + r) * 136 + 32 * s + 8 * q), k1 = *(const LAS bf16x8*)(Kn + (32 * s2 + 16 + r) * 136 + 32 * s + 8 * q);
            a0 = MFMA16(k0, bq, a0); a1 = MFMA16(k1, bq, a1); }
        const int i = 16 * ib + r; const float gi = sg[i]; f32x4 o0, o1;
#pragma unroll
        for (int d = 0; d < 4; ++d) { const int j0 = 32 * s2 + 4 * q + d, j1 = j0 + 16;
            o0[d] = (j0 <= i) ? a0[d] * __expf(gi - sg[j0]) : 0.f; o1[d] = (j1 <= i) ? a1[d] * __expf(gi - sg[j1]) : 0.f; }
        *(bf16x8*)(img + 32768 + ((ib * 2 + s2) * 64 + lane) * 16) = pack8(o0, o1); }
}
__device__ __forceinline__ void gdn_solve(const Ctx& c, const GdnLds& P, int copy) {
    const int lane = c.lane;
    float Tc[64];
    int zoff = 0; asm volatile("v_mov_b32 %0, 0" : "=v"(zoff));
    const LAS float* Lz = P.Lm + zoff;
    const float scl = P.sb[lane] * (copy == 0 ? 1.f : expf(P.sg[lane]));
#define LROW(dst, row, half, nv) do { _Pragma("unroll") for (int _k = 0; _k < (nv); ++_k) dst[_k] = *(const LAS f32x4*)(Lz + (row) * 68 + 32 * (half) + 4 * _k); } while (0)
    f32x4 X[8], Y[8];
    Tc[0] = (lane == 0) ? scl : 0.f;
    LROW(Y, 1, 0, 1);
#pragma unroll
    for (int i = 1; i < 32; ++i) {
        if (i & 1) LROW(X, i + 1, 0, (i + 4) / 4 > 8 ? 8 : (i + 4) / 4); else LROW(Y, i + 1, 0, (i + 4) / 4 > 8 ? 8 : (i + 4) / 4);
        __builtin_amdgcn_sched_barrier(0);
        float a0 = (i == lane) ? scl : 0.f, a1 = 0.f, a2 = 0.f, a3 = 0.f;
#pragma unroll
        for (int m = 0; m < i; ++m) { const float lv = ((i & 1) ? Y[m >> 2][m & 3] : X[m >> 2][m & 3]);
            if ((m & 3) == 0) a0 -= lv * Tc[m]; else if ((m & 3) == 1) a1 -= lv * Tc[m]; else if ((m & 3) == 2) a2 -= lv * Tc[m]; else a3 -= lv * Tc[m]; }
        Tc[i] = (a0 + a1) + (a2 + a3);
        __builtin_amdgcn_sched_barrier(0);
    }
#pragma unroll
    for (int i = 32; i < 64; ++i) {
        if (i > 32) LROW(Y, i, 1, (i - 32 + 3) / 4);
        __builtin_amdgcn_sched_barrier(0);
        float a0 = (i == lane) ? scl : 0.f, a1 = 0.f, a2 = 0.f, a3 = 0.f;
#pragma unroll
        for (int m = 0; m < 32; ++m) { const float lv = X[m >> 2][m & 3];
            if ((m & 3) == 0) a0 -= lv * Tc[m]; else if ((m & 3) == 1) a1 -= lv * Tc[m]; else if ((m & 3) == 2) a2 -= lv * Tc[m]; else a3 -= lv * Tc[m]; }
        __builtin_amdgcn_sched_barrier(0);
        if (i + 1 < 64) LROW(X, i + 1, 0, 8);
        __builtin_amdgcn_sched_barrier(0);
#pragma unroll
        for (int m = 32; m < i; ++m) { const float lv = Y[(m - 32) >> 2][m & 3];
            if ((m & 3) == 0) a0 -= lv * Tc[m]; else if ((m & 3) == 1) a1 -= lv * Tc[m]; else if ((m & 3) == 2) a2 -= lv * Tc[m]; else a3 -= lv * Tc[m]; }
        Tc[i] = (a0 + a1) + (a2 + a3);
        __builtin_amdgcn_sched_barrier(0);
    }
#undef LROW
    LAS bf16* Td = P.Tm + copy * 4608;
#pragma unroll
    for (int i = 0; i < 64; ++i) Td[i * 72 + lane] = (bf16)f2bf(Tc[i]);
}
__device__ __forceinline__ void gdn_exports(const Ctx& c, int ug, const GdnLds& P, int w6) {
    const int lane = c.lane, q = lane >> 4, r = lane & 15;
    unsigned char* img = c.gimg + (size_t)ug * GIMG_BYTES;
    LAS bf16* Qn = P.Qn; LAS bf16* Kn = P.Kn; LAS float* sg = P.sg;
    const float glast = sg[63];
    for (int f = w6; f < 32; f += 6) {
        if (f < 16) { const int mb = f >> 2, s = f & 3, i = 16 * mb + r; const LAS bf16* p = Qn + i * 136 + 32 * s + 4 * q;
            const v2u lo = *(const LAS v2u*)p, hi = *(const LAS v2u*)(p + 16); const float eg = __expf(sg[i]);
            const f32x4 a = {bflo(lo.x) * eg, bfhi(lo.x) * eg, bflo(lo.y) * eg, bfhi(lo.y) * eg}, bb = {bflo(hi.x) * eg, bfhi(hi.x) * eg, bflo(hi.y) * eg, bfhi(hi.y) * eg};
            *(bf16x8*)(img + 16384 + ((mb * 4 + s) * 64 + lane) * 16) = pack8(a, bb);
        } else { const int ff = f - 16, db = ff >> 1, s2 = ff & 1, dk = 16 * db + r; f32x4 a, bb;
#pragma unroll
            for (int e = 0; e < 4; ++e) { const int j0 = 32 * s2 + 4 * q + e, j1 = j0 + 16;
                a[e] = bf2f(Kn[j0 * 136 + dk]) * __expf(glast - sg[j0]); bb[e] = bf2f(Kn[j1 * 136 + dk]) * __expf(glast - sg[j1]); }
            *(bf16x8*)(img + 40960 + ((db * 2 + s2) * 64 + lane) * 16) = pack8(a, bb); }
    }
}
__device__ __forceinline__ void gdn_step4(const Ctx& c, int ug, const GdnLds& P) {
    const int lane = c.lane, q = lane >> 4, r = lane & 15, w = c.wave;
    unsigned char* img = c.gimg + (size_t)ug * GIMG_BYTES; float* uimg = c.gu + (size_t)ug * 8192;
    LAS bf16* Tm = P.Tm; LAS bf16* Vt = P.Vt; LAS bf16* Kt = P.Kt;
#pragma unroll
    for (int mb = 0; mb < 4; ++mb) { f32x4 acc = {0.f, 0.f, 0.f, 0.f};
#pragma unroll
        for (int s2 = 0; s2 < 2; ++s2) { const bf16x8 a = *(const LAS bf16x8*)(Tm + (16 * mb + r) * 72 + 32 * s2 + 8 * q), bb = *(const LAS bf16x8*)(Vt + TP(16 * w + r) * 72 + 32 * s2 + 8 * q); acc = MFMA16(a, bb, acc); }
        { v2u pw; pw.x = cvt2(acc[0], acc[1]); pw.y = cvt2(acc[2], acc[3]); *(v2u*)((bf16*)uimg + ((w * 4 + mb) * 64 + lane) * 4) = pw; } }
#pragma unroll
    for (int ff = 0; ff < 2; ++ff) { const int f = 2 * w + ff, mb = f >> 2, s = f & 3;
        f32x4 a0 = {0.f, 0.f, 0.f, 0.f}, a1 = {0.f, 0.f, 0.f, 0.f};
#pragma unroll
        for (int s2 = 0; s2 < 2; ++s2) { const bf16x8 bt = *(const LAS bf16x8*)(Tm + 4608 + (16 * mb + r) * 72 + 32 * s2 + 8 * q);
            const bf16x8 k0 = *(const LAS bf16x8*)(Kt + TP(32 * s + r) * 72 + 32 * s2 + 8 * q), k1 = *(const LAS bf16x8*)(Kt + TP(32 * s + 16 + r) * 72 + 32 * s2 + 8 * q);
            a0 = MFMA16(k0, bt, a0); a1 = MFMA16(k1, bt, a1); }
        *(bf16x8*)(img + ((mb * 4 + s) * 64 + lane) * 16) = pack8(-a0, -a1); }
}
__device__ __forceinline__ void prep_gdn_all(const Ctx& c) {
    GdnLds P;
    P.sb = (LAS float*)c.lds; P.sg = P.sb + 64;
    P.Qn = (LAS bf16*)(c.lds + 1024);
    P.Kn = (LAS bf16*)(c.lds + 18432);
    P.Vt = (LAS bf16*)(c.lds + 35840);
    P.Kt = (LAS bf16*)(c.lds + 55296);
    P.Lm = (LAS float*)(c.lds + 74752);
    P.Tm = (LAS bf16*)(c.lds + 92160);
    const int w = c.wave;
    v4u rows[8], cols[8]; float beta = 0.f, g = 0.f;
#pragma unroll
    for (int i = 0; i < 8; ++i) { rows[i] = (v4u){0u, 0u, 0u, 0u}; cols[i] = (v4u){0u, 0u, 0u, 0u}; }
    int ug = c.bid;
    if (ug < 2048 && w < 6) gdn_conv_compute(c, ug, rows, cols, beta, g);
    for (; ug < 2048; ug += c.G) {
        if (w < 6) gdn_conv_write(c, ug, P, rows, cols, beta, g);
        __syncthreads();
        gdn_step2(c, ug, P);
        __syncthreads();
        if (w >= 6) { gdn_solve(c, P, w - 6);
#pragma unroll
            for (int i = 0; i < 8; ++i) { rows[i] = (v4u){0u, 0u, 0u, 0u}; cols[i] = (v4u){0u, 0u, 0u, 0u}; } }
        else { gdn_exports(c, ug, P, w); if (ug + c.G < 2048) gdn_conv_compute(c, ug + c.G, rows, cols, beta, g); }
        __syncthreads();
        gdn_step4(c, ug, P);
        __syncthreads();
    }
}
#undef TP
__device__ __forceinline__ void prep_ret(const Ctx& c, int ur) {
    const int n = ur & 63, h = (ur >> 6) & 3, b = ur >> 8, t0 = n * 64;
    const size_t rowbase = (size_t)b * SEQ + t0;
    const int lane = c.lane, q = lane >> 4, r = lane & 15, w = c.wave;
    LAS bf16* Qr = (LAS bf16*)c.lds;
    LAS bf16* Kr = (LAS bf16*)(c.lds + 33792);
    LAS bf16* Vt = (LAS bf16*)(c.lds + 67584);
    unsigned char* img = c.rimg + (size_t)ur * RIMG_BYTES; float* inner = c.rinner + (size_t)ur * 16384; unsigned char* vf = c.rvf + (size_t)ur * 32768;
    const float lg2 = log2f(1.f - exp2f(-5.f - (float)h));
    {
        v4u qa[2], qb[2], ka[2], kb[2]; f32x4 cs[2][4];
#pragma unroll
        for (int it = 0; it < 2; ++it) { const int item = it * NTHREADS + c.tid, tok = item >> 4, i0 = (item & 15) * 8; const size_t row = rowbase + tok;
            const bf16* pr = c.PROJ + row * NPROJ + 4096 + h * 256 + i0;
            qa[it] = *(const v4u*)pr; qb[it] = *(const v4u*)(pr + 128); ka[it] = *(const v4u*)(pr + 1024); kb[it] = *(const v4u*)(pr + 1024 + 128);
            const f32x4* rp = (const f32x4*)(c.rot + row * 128 + i0);
#pragma unroll
            for (int p = 0; p < 4; ++p) cs[it][p] = rp[p]; }
#pragma unroll
        for (int it = 0; it < 2; ++it) { const int item = it * NTHREADS + c.tid, tok = item >> 4, i0 = (item & 15) * 8;
            const unsigned qaw[4] = {qa[it].x, qa[it].y, qa[it].z, qa[it].w}, qbw[4] = {qb[it].x, qb[it].y, qb[it].z, qb[it].w}, kaw[4] = {ka[it].x, ka[it].y, ka[it].z, ka[it].w}, kbw[4] = {kb[it].x, kb[it].y, kb[it].z, kb[it].w};
            unsigned oq1[4], oq2[4], ok1[4], ok2[4];
#pragma unroll
            for (int p = 0; p < 4; ++p) { float r1[2], r2[2], r3[2], r4[2];
#pragma unroll
                for (int hh = 0; hh < 2; ++hh) { const float cc = hh ? cs[it][p].z : cs[it][p].x, sn = hh ? cs[it][p].w : cs[it][p].y;
                    const float x1 = hh ? bfhi(qaw[p]) : bflo(qaw[p]), x2 = hh ? bfhi(qbw[p]) : bflo(qbw[p]), y1 = hh ? bfhi(kaw[p]) : bflo(kaw[p]), y2 = hh ? bfhi(kbw[p]) : bflo(kbw[p]);
                    r1[hh] = x1 * cc - x2 * sn; r2[hh] = x2 * cc + x1 * sn; r3[hh] = (y1 * cc - y2 * sn) * 0.0625f; r4[hh] = (y2 * cc + y1 * sn) * 0.0625f; }
                oq1[p] = pk2(r1[0], r1[1]); oq2[p] = pk2(r2[0], r2[1]); ok1[p] = pk2(r3[0], r3[1]); ok2[p] = pk2(r4[0], r4[1]); }
            v4u t;
            t.x = oq1[0]; t.y = oq1[1]; t.z = oq1[2]; t.w = oq1[3]; *(LAS v4u*)(Qr + tok * 264 + i0) = t;
            t.x = oq2[0]; t.y = oq2[1]; t.z = oq2[2]; t.w = oq2[3]; *(LAS v4u*)(Qr + tok * 264 + 128 + i0) = t;
            t.x = ok1[0]; t.y = ok1[1]; t.z = ok1[2]; t.w = ok1[3]; *(LAS v4u*)(Kr + tok * 264 + i0) = t;
            t.x = ok2[0]; t.y = ok2[1]; t.z = ok2[2]; t.w = ok2[3]; *(LAS v4u*)(Kr + tok * 264 + 128 + i0) = t; }
    }
    { v4u vv[4];
#pragma unroll
        for (int it = 0; it < 4; ++it) { const int item = it * NTHREADS + c.tid, tok = item & 63, vg = item >> 6; vv[it] = *(const v4u*)(c.PROJ + (rowbase + tok) * NPROJ + 6144 + h * 256 + 8 * vg); }
#pragma unroll
        for (int it = 0; it < 4; ++it) { const int item = it * NTHREADS + c.tid, tok = item & 63, vg = item >> 6; const v4u u = vv[it];
            LAS bf16* d = Vt + (8 * vg) * 72 + tok;
            d[0] = (bf16)(u.x & 0xffff); d[72] = (bf16)(u.x >> 16); d[144] = (bf16)(u.y & 0xffff); d[216] = (bf16)(u.y >> 16);
            d[288] = (bf16)(u.z & 0xffff); d[360] = (bf16)(u.z >> 16); d[432] = (bf16)(u.w & 0xffff); d[504] = (bf16)(u.w >> 16); } }
    __syncthreads();
    {
        const int ib = w >> 1, half = w & 1, i = 16 * ib + r;
        bf16x8 scf[2];
#pragma unroll
        for (int s2 = 0; s2 < 2; ++s2) { f32x4 a0 = {0.f, 0.f, 0.f, 0.f}, a1 = {0.f, 0.f, 0.f, 0.f};
#pragma unroll
            for (int s = 0; s < 8; ++s) { const bf16x8 bq = *(const LAS bf16x8*)(Qr + i * 264 + 32 * s + 8 * q);
                const bf16x8 k0 = *(const LAS bf16x8*)(Kr + (32 * s2 + r) * 264 + 32 * s + 8 * q), k1 = *(const LAS bf16x8*)(Kr + (32 * s2 + 16 + r) * 264 + 32 * s + 8 * q);
                a0 = MFMA16(k0, bq, a0); a1 = MFMA16(k1, bq, a1); }
            f32x4 o0, o1;
#pragma unroll
            for (int d = 0; d < 4; ++d) { const int j0 = 32 * s2 + 4 * q + d, j1 = j0 + 16;
                o0[d] = (j0 <= i) ? a0[d] * exp2f((float)(i - j0) * lg2) : 0.f; o1[d] = (j1 <= i) ? a1[d] * exp2f((float)(i - j1) * lg2) : 0.f; }
            scf[s2] = pack8(o0, o1); }
#pragma unroll
        for (int x = 0; x < 8; ++x) { const int nb = 8 * half + x; f32x4 acc = {0.f, 0.f, 0.f, 0.f};
#pragma unroll
            for (int s2 = 0; s2 < 2; ++s2) { const LAS bf16* p = Vt + (16 * nb + r) * 72 + 32 * s2 + 4 * q; acc = MFMA16(scf[s2], ld2x8(p, p + 16), acc); }
            { v2u pw; pw.x = cvt2(acc[0], acc[1]); pw.y = cvt2(acc[2], acc[3]); *(v2u*)((bf16*)inner + ((nb * 4 + ib) * 64 + lane) * 4) = pw; } }
    }
#pragma unroll
    for (int x = 0; x < 4; ++x) { const int nb = 2 * w + (x >> 1), s2 = x & 1; const LAS bf16* p = Vt + (16 * nb + r) * 72 + 32 * s2 + 4 * q;
        *(bf16x8*)(vf + ((nb * 2 + s2) * 64 + lane) * 16) = ld2x8(p, p + 16); }
#pragma unroll 1
    for (int f = w; f < 32; f += 8) { const int mb = f >> 3, s = f & 7, i = 16 * mb + r; const LAS bf16* p = Qr + i * 264 + 32 * s + 4 * q;
        const v2u lo = *(const LAS v2u*)p, hi = *(const LAS v2u*)(p + 16); const float eg = exp2f((float)(i + 1) * lg2);
        const f32x4 a = {bflo(lo.x) * eg, bfhi(lo.x) * eg, bflo(lo.y) * eg, bfhi(lo.y) * eg}, bb = {bflo(hi.x) * eg, bfhi(hi.x) * eg, bflo(hi.y) * eg, bfhi(hi.y) * eg};
        *(bf16x8*)(img + ((mb * 8 + s) * 64 + lane) * 16) = pack8(a, bb); }
#pragma unroll 1
    for (int f = w; f < 32; f += 8) { const int db = f >> 1, s2 = f & 1, dk = 16 * db + r; f32x4 a, bb;
#pragma unroll
        for (int e = 0; e < 4; ++e) { const int j0 = 32 * s2 + 4 * q + e, j1 = j0 + 16;
            a[e] = bf2f(Kr[j0 * 264 + dk]) * exp2f((float)(63 - j0) * lg2); bb[e] = bf2f(Kr[j1 * 264 + dk]) * exp2f((float)(63 - j1) * lg2); }
        *(bf16x8*)(img + 32768 + ((db * 2 + s2) * 64 + lane) * 16) = pack8(a, bb); }
    __syncthreads();
}
__device__ __forceinline__ void stage_image(LAS unsigned char* dst, const unsigned char* src, int npieces, int tid, int wave) {
    for (int k = 0; k < npieces; ++k)
        __builtin_amdgcn_global_load_lds((const unsigned*)(src + k * 8192 + tid * 16), (LAS unsigned*)(dst + k * 8192 + wave * 1024), 16, 0, 0);
}
__device__ __forceinline__ f32x4 gload16(const void* p) { return *(const f32x4*)p; }
__device__ __forceinline__ f32x4 gload8bf(const void* p) { const v2u w = *(const v2u*)p; return (f32x4){bflo(w.x), bfhi(w.x), bflo(w.y), bfhi(w.y)}; }
#define SCAN_WAIT4(n, a, b, cc, d) asm volatile("s_waitcnt vmcnt(" #n ")" : "+v"(a), "+v"(b), "+v"(cc), "+v"(d) :: "memory")
#define SCAN_WAIT2(n, a, b) asm volatile("s_waitcnt vmcnt(" #n ")" : "+v"(a), "+v"(b) :: "memory")
#define LDF(off) (*(const LAS bf16x8*)(buf + (off) + lane * 16))
#define SB() __builtin_amdgcn_sched_barrier(0)
__device__ __forceinline__ void scan_gdn(const Ctx& c, int u) {
    const int bh = u, b = bh >> 3, h = bh & 7, w = c.wave, lane = c.lane, q = lane >> 4, r = lane & 15;
    const bool active = true; const int dvb = w;
    const unsigned char* img0 = c.gimg + (size_t)bh * 64 * GIMG_BYTES;
    const bf16* u0 = (const bf16*)c.gu + (size_t)bh * 64 * 16384 + (dvb * 4) * 256 + lane * 4;
    bf16* obase = c.Ob + ((size_t)b * SEQ + 4 * q) * D + h * 128 + 16 * dvb + r;
    LAS float* cdl = (LAS float*)(c.lds + 2 * GIMG_BYTES);
    if (c.tid < 64) cdl[c.tid] = c.gcd[bh * 64 + c.tid];
    f32x4 S[8];
#pragma unroll
    for (int i = 0; i < 8; ++i) S[i] = (f32x4){0.f, 0.f, 0.f, 0.f};
    f32x4 U0, U1, U2, U3, N0, N1, N2, N3;
    stage_image(c.lds, img0, 7, c.tid, w);
    U0 = gload8bf(u0); U1 = gload8bf(u0 + 256); U2 = gload8bf(u0 + 512); U3 = gload8bf(u0 + 768);
    SCAN_WAIT4(0, U0, U1, U2, U3); N0 = U0; N1 = U1; N2 = U2; N3 = U3;
    __syncthreads();
#pragma unroll 1
    for (int n = 0; n < 64; ++n) {
        const LAS unsigned char* buf = c.lds + (n & 1) * GIMG_BYTES;
        if (n + 1 < 64) { stage_image(c.lds + ((n + 1) & 1) * GIMG_BYTES, img0 + (size_t)(n + 1) * GIMG_BYTES, 7, c.tid, w);
            const bf16* un = u0 + (size_t)(n + 1) * 16384; N0 = gload8bf(un); N1 = gload8bf(un + 256); N2 = gload8bf(un + 512); N3 = gload8bf(un + 768); }
        if (active) {
            const float cd = cdl[n];
            bf16x8 Sf[4];
#pragma unroll
            for (int s = 0; s < 4; ++s) Sf[s] = pack8(S[2 * s], S[2 * s + 1]);
            f32x4 D1[4]; D1[0] = U0; D1[1] = U1; D1[2] = U2; D1[3] = U3;
            f32x4 Oa[4];
            bf16x8 Df[2];
            bf16x8 fa[4], fb[4];
#pragma unroll
            for (int f = 0; f < 4; ++f) fa[f] = LDF(f * 1024);
            SB();
#pragma unroll
            for (int bt = 0; bt < 14; ++bt) {
                if (bt + 1 < 14) {
#pragma unroll
                    for (int f = 0; f < 4; ++f) { if (bt & 1) fa[f] = LDF(((bt + 1) * 4 + f) * 1024); else fb[f] = LDF(((bt + 1) * 4 + f) * 1024); }
                }
                SB();
                if (bt < 4) {
#pragma unroll
                    for (int f = 0; f < 4; ++f) D1[bt] = MFMA16((bt & 1) ? fb[f] : fa[f], Sf[f], D1[bt]);
                    if (bt == 3) { Df[0] = pack8(D1[0], D1[1]); Df[1] = pack8(D1[2], D1[3]); }
                } else if (bt < 8) {
                    f32x4 acc = {0.f, 0.f, 0.f, 0.f};
#pragma unroll
                    for (int f = 0; f < 4; ++f) acc = MFMA16((bt & 1) ? fb[f] : fa[f], Sf[f], acc);
                    Oa[bt - 4] = acc;
                } else if (bt < 10) {
#pragma unroll
                    for (int x = 0; x < 2; ++x) { const int mb = 2 * (bt - 8) + x; f32x4 acc = Oa[mb];
                        acc = MFMA16((bt & 1) ? fb[2 * x] : fa[2 * x], Df[0], acc); acc = MFMA16((bt & 1) ? fb[2 * x + 1] : fa[2 * x + 1], Df[1], acc);
                        bf16* op = obase + (size_t)(n * 64 + 16 * mb) * D;
                        op[0] = (bf16)f2bf(acc[0]); op[D] = (bf16)f2bf(acc[1]); op[2 * D] = (bf16)f2bf(acc[2]); op[3 * D] = (bf16)f2bf(acc[3]); }
                } else {
#pragma unroll
                    for (int x = 0; x < 2; ++x) { const int db = 2 * (bt - 10) + x; f32x4 acc = S[db] * cd;
                        acc = MFMA16((bt & 1) ? fb[2 * x] : fa[2 * x], Df[0], acc); acc = MFMA16((bt & 1) ? fb[2 * x + 1] : fa[2 * x + 1], Df[1], acc); S[db] = acc; }
                }
                SB();
            }
        }
        if (active) SCAN_WAIT4(16, N0, N1, N2, N3); else SCAN_WAIT4(0, N0, N1, N2, N3);
        U0 = N0; U1 = N1; U2 = N2; U3 = N3;
        LDS_WAIT(); __builtin_amdgcn_s_barrier(); asm volatile("" ::: "memory");
    }
}
__device__ __forceinline__ void scan_ret(const Ctx& c, int u) {
    const int qt = u & 1, bh = u >> 1, b = bh >> 2, h = bh & 3, w = c.wave, lane = c.lane, q = lane >> 4, r = lane & 15;
    const bool active = true; const int nb = 8 * qt + w;
    const unsigned char* img0 = c.rimg + (size_t)bh * 64 * RIMG_BYTES;
    const bf16* in0 = (const bf16*)c.rinner + (size_t)bh * 64 * 32768 + (nb * 4) * 256 + lane * 4;
    const unsigned char* vf0 = c.rvf + (size_t)bh * 64 * 32768 + ((nb * 2) * 64 + lane) * 16;
    bf16* obase = c.Ob + ((size_t)b * SEQ + 4 * q) * D + 1024 + h * 256 + 16 * nb + r;
    const float cd = exp2f(64.f * log2f(1.f - exp2f(-5.f - (float)h)));
    f32x4 S[16];
#pragma unroll
    for (int i = 0; i < 16; ++i) S[i] = (f32x4){0.f, 0.f, 0.f, 0.f};
    f32x4 I0, I1, I2, I3, N0, N1, N2, N3, V0, V1, W0, W1;
    stage_image(c.lds, img0, 8, c.tid, w);
    I0 = gload8bf(in0); I1 = gload8bf(in0 + 256); I2 = gload8bf(in0 + 512); I3 = gload8bf(in0 + 768); V0 = gload16(vf0); V1 = gload16(vf0 + 1024);
    SCAN_WAIT4(0, I0, I1, I2, I3); SCAN_WAIT2(0, V0, V1); N0 = I0; N1 = I1; N2 = I2; N3 = I3; W0 = V0; W1 = V1;
    __syncthreads();
#pragma unroll 1
    for (int n = 0; n < 64; ++n) {
        const LAS unsigned char* buf = c.lds + (n & 1) * RIMG_BYTES;
        if (n + 1 < 64) { stage_image(c.lds + ((n + 1) & 1) * RIMG_BYTES, img0 + (size_t)(n + 1) * RIMG_BYTES, 8, c.tid, w);
            const bf16* inn = in0 + (size_t)(n + 1) * 32768; const unsigned char* vn = vf0 + (size_t)(n + 1) * 32768;
            N0 = gload8bf(inn); N1 = gload8bf(inn + 256); N2 = gload8bf(inn + 512); N3 = gload8bf(inn + 768); W0 = gload16(vn); W1 = gload16(vn + 1024); }
        if (active) {
            bf16x8 Sf[8];
#pragma unroll
            for (int s = 0; s < 8; ++s) Sf[s] = pack8(S[2 * s], S[2 * s + 1]);
            const bf16x8 Vf0 = __builtin_bit_cast(bf16x8, V0), Vf1 = __builtin_bit_cast(bf16x8, V1);
            f32x4 Oa[4]; Oa[0] = I0; Oa[1] = I1; Oa[2] = I2; Oa[3] = I3;
            bf16x8 fa[4], fb[4];
#pragma unroll
            for (int f = 0; f < 4; ++f) fa[f] = LDF(f * 1024);
            SB();
#pragma unroll
            for (int bt = 0; bt < 16; ++bt) {
                if (bt + 1 < 16) {
#pragma unroll
                    for (int f = 0; f < 4; ++f) { if (bt & 1) fa[f] = LDF(((bt + 1) * 4 + f) * 1024); else fb[f] = LDF(((bt + 1) * 4 + f) * 1024); }
                }
                SB();
                if (bt < 8) { const int mb = bt >> 1; f32x4 acc = Oa[mb];
#pragma unroll
                    for (int f = 0; f < 4; ++f) acc = MFMA16((bt & 1) ? fb[f] : fa[f], Sf[4 * (bt & 1) + f], acc);
                    Oa[mb] = acc;
                    if (bt & 1) { bf16* op = obase + (size_t)(n * 64 + 16 * mb) * D; op[0] = (bf16)f2bf(acc[0]); op[D] = (bf16)f2bf(acc[1]); op[2 * D] = (bf16)f2bf(acc[2]); op[3 * D] = (bf16)f2bf(acc[3]); }
                } else {
#pragma unroll
                    for (int x = 0; x < 2; ++x) { const int db = 2 * (bt - 8) + x; f32x4 acc = S[db] * cd;
                        acc = MFMA16((bt & 1) ? fb[2 * x] : fa[2 * x], Vf0, acc); acc = MFMA16((bt & 1) ? fb[2 * x + 1] : fa[2 * x + 1], Vf1, acc); S[db] = acc; }
                }
                SB();
            }
        }
        if (active) { SCAN_WAIT4(16, N0, N1, N2, N3); SCAN_WAIT2(16, W0, W1); } else { SCAN_WAIT4(0, N0, N1, N2, N3); SCAN_WAIT2(0, W0, W1); }
        I0 = N0; I1 = N1; I2 = N2; I3 = N3; V0 = W0; V1 = W1;
        LDS_WAIT(); __builtin_amdgcn_s_barrier(); asm volatile("" ::: "memory");
    }
}
#undef LDF
#undef SB
__device__ __forceinline__ void ph_mixer_prep(const Ctx& c) {
    prep_gdn_all(c);
    for (int u = c.bid; u < 1024; u += c.G) prep_ret(c, u);
}
__device__ __forceinline__ void ph_mixer_scan(const Ctx& c) {
    for (int u = c.bid; u < SCAN_UNITS; u += c.G) { if (u < 32) scan_gdn(c, u); else { const int v = u - 32, xcd = v & 7, grp = v >> 3; scan_ret(c, (xcd + 8 * (grp >> 1)) * 2 + (grp & 1)); } __syncthreads(); }
    if (c.G > SCAN_UNITS) {
        unsigned* qw = (unsigned*)c.ctl + CW_CONVQ;
        LAS unsigned* slot = (LAS unsigned*)(c.lds + 8 * 8704);
        LAS float* scr = (LAS float*)(c.lds + c.wave * 8704);
        for (;;) {
            __syncthreads();
            if (c.tid == 0) *slot = __hip_atomic_fetch_add(qw, 16u, __ATOMIC_RELAXED, __HIP_MEMORY_SCOPE_AGENT);
            __syncthreads();
            const unsigned base = *slot;
            if (base >= (unsigned)(IT_ALL - IT_SMALL)) break;
            const float *Wa, *Wb; int la, lb, sa, sb2, ka, kb2; unsigned char *Ta, *Tb; size_t da, db;
            f8item_addr(c, (int)base + c.wave, Wa, la, sa, ka, Ta, da); f8item_addr(c, (int)base + 8 + c.wave, Wb, lb, sb2, kb2, Tb, db);
            f32x4 ra[8], rb[8];
            f8item_load(Wa, la, sa, ka, c.lane, ra); f8item_load(Wb, lb, sb2, kb2, c.lane, rb);
            f8item_emit(ra, Ta, da, ka, scr, c.lane); f8item_emit(rb, Tb, db, kb2, scr, c.lane);
        }
    }
}

__device__ __forceinline__ void ph_gemm_inproj(const Ctx& c) {
    pg8::Sched S; S.init(c.H, c.win_t, nullptr, T / 256, NPROJ, c.G, c.bid, (size_t)D * 2);
    pg8::gemm_phase(c.lds, S, pg8::EpiProj{c.PROJ, NPROJ});
}
__device__ __forceinline__ void ph_gemm_outproj(const Ctx& c) {
    pg8::Sched S; S.init(c.H, c.wout_t, nullptr, T / 256, D, c.G, c.bid, (size_t)D * 2);
    pg8::gemm_phase(c.lds, S, pg8::EpiResid{c.x, c.mod, c.X1});
}
__device__ __forceinline__ void ph_gemm_up(const Ctx& c) {
    const int nmt = __builtin_amdgcn_readfirstlane(c.meta[0]);
    pg8::Sched S; S.init(c.XS8, c.w1_q, c.tile_e, nmt, 4096, c.G, c.bid, (size_t)D);
    pg8::gemm_phase_f8(c.lds, S, pg8::EpiUpF8{c.ACT8, c.b1, c.tile_e});
}
__device__ __forceinline__ void ph_gemm_down(const Ctx& c) {
    const int nmt = __builtin_amdgcn_readfirstlane(c.meta[0]);
    pg8::Sched S; S.init(c.ACT8, c.w2_q, c.tile_e, nmt, D, c.G, c.bid, (size_t)D);
    pg8::gemm_phase_f8(c.lds, S, pg8::EpiDown{c.Y, c.b2, c.tile_e, c.row_gate});
}

struct Args { const void* in[22]; float* out; unsigned char* ws; int ph_lo, ph_hi, li, pad; };
__global__ void __launch_bounds__(NTHREADS, 2) fwd_kernel(Args a) {
    extern __shared__ __attribute__((aligned(16))) unsigned char lds_raw[];
    Ctx c;
    c.lds = (LAS unsigned char*)lds_raw;
    c.tid = threadIdx.x; c.lane = c.tid & 63; c.wave = __builtin_amdgcn_readfirstlane(c.tid >> 6); c.G = gridDim.x; c.bid = blockIdx.x;
    c.x = (const float*)a.in[0]; c.c_in = (const float*)a.in[1]; c.positions = (const int*)a.in[2];
    c.ada_w = (const float*)a.in[3]; c.ada_b = (const float*)a.in[4]; c.norm1_g = (const float*)a.in[5]; c.w_in = (const float*)a.in[6]; c.conv_w = (const float*)a.in[7];
    c.a_log = (const float*)a.in[8]; c.dt_bias = (const float*)a.in[9]; c.gdn_norm_g = (const float*)a.in[10]; c.ret_norm_g = (const float*)a.in[11]; c.ret_norm_b = (const float*)a.in[12];
    c.w_out = (const float*)a.in[13]; c.norm2_g = (const float*)a.in[14]; c.w_router = (const float*)a.in[15]; c.b_router = (const float*)a.in[16];
    c.w1 = (const float*)a.in[17]; c.b1 = (const float*)a.in[18]; c.w2 = (const float*)a.in[19]; c.b2 = (const float*)a.in[20]; c.final_g = (const float*)a.in[21];
    c.out = a.out;
    unsigned char* ws = a.ws;
    c.ctl = (unsigned*)(ws + WS_CTL); c.mod = (float*)(ws + WS_MOD); c.tok_e = (int*)(ws + WS_TOKE); c.tok_g = (float*)(ws + WS_TOKG); c.tok_pos = (int*)(ws + WS_TOKP); c.blk_cnt = (int*)(ws + WS_BCNT);
    c.tile_e = (int*)(ws + WS_TILEE); c.meta = (int*)(ws + WS_META); c.row_gate = (float*)(ws + WS_RGATE); c.row_tok = (int*)(ws + WS_RTOK);
    c.ba = (float*)(ws + WS_BA); c.wba_t = (float*)(ws + WS_WBAT); c.wr_t = (float*)(ws + WS_WRT);
    c.win_t = (bf16*)(ws + WS_WIN); c.wout_t = (bf16*)(ws + WS_WOUT); c.w1_q = ws + WS_W1; c.w2_q = ws + WS_W2;
    c.H = (bf16*)(ws + WS_H); c.PROJ = (bf16*)(ws + WS_PROJ); c.Y = (bf16*)(ws + WS_Y); c.H8 = ws + WS_H + 32 * MiB; c.XS8 = ws + WS_XS; c.ACT8 = ws + WS_ACT;
    c.O = (float*)(ws + WS_O); c.Ob = (bf16*)(ws + WS_O); c.X1 = (bf16*)(ws + WS_X1);
    c.gimg = ws + WS_GIMG; c.rimg = ws + WS_RIMG; c.rvf = ws + WS_RVF; c.gu = (float*)(ws + WS_GU); c.rinner = (float*)(ws + WS_RINNER); c.gcd = (float*)(ws + WS_GCD); c.rot = (f32x2*)(ws + WS_ROT);

    volatile LAS unsigned* misc = (volatile LAS unsigned*)(c.lds + MISC_OFF);
    if (c.tid < 16) misc[c.tid] = 0u;
    __syncthreads();
    XcdBarrier bar; bar.bar = (unsigned*)(ws + WS_CTL) + CW_BAR + a.li * XCD_BAR_WORDS; bar.x = 0; bar.st = misc;
    if (N_LAUNCH_MODE == 1) bar = xcd_barrier_post((unsigned*)(ws + WS_CTL) + CW_BAR + a.li * XCD_BAR_WORDS, misc);
    const int lo = a.ph_lo, hi = a.ph_hi;
#ifdef ONLY_PHASE
#define IN(k) ((k) == ONLY_PHASE && lo <= (k) && (k) < hi)
#else
#define IN(k) (lo <= (k) && (k) < hi)
#endif
#define SEAM(k) do { if (N_LAUNCH_MODE == 1 && IN(k) && IN((k) + 1)) xcd_barrier(bar); else __syncthreads(); } while (0)
    if (IN(0)) { ph_prologue(c); } SEAM(0);
    if (IN(1)) { ph_norm1(c); } SEAM(1);
    if (IN(2)) { ph_gemm_inproj(c); } SEAM(2);
#if NAIVE_MIXER
    if (IN(3)) { } SEAM(3);
    if (IN(4)) { ph_mixer_naive(c); } SEAM(4);
#else
    if (IN(3)) { ph_mixer_prep(c); } SEAM(3);
    if (IN(4)) { ph_mixer_scan(c); } SEAM(4);
#endif
    if (IN(5)) { ph_gatenorm(c); } SEAM(5);
    if (IN(6)) { ph_gemm_outproj(c); } SEAM(6);
    if (IN(7)) { ph_router(c); } SEAM(7);
    if (IN(8)) { ph_route2(c); } SEAM(8);
    if (IN(9)) { ph_gemm_up(c); } SEAM(9);
    if (IN(10)) { ph_gemm_down(c); } SEAM(10);
    if (IN(11)) { ph_final(c); }
#undef IN
#undef SEAM
}

extern "C" void kernel_launch(void* const* d_in, const int* in_sizes, int n_in, void* d_out, int out_size, void* d_ws, size_t ws_size, hipStream_t stream) {
    static int grid = 0;
    if (grid == 0) {
        if (n_in != 22 || out_size != T * D || ws_size < WS_END) { fprintf(stderr, "kernel_launch: unexpected shapes (n_in %d out %d ws %zu)\n", n_in, out_size, ws_size); grid = -1; return; }
        int dev = 0, cus = 0, per_cu = 0;
        if (hipGetDevice(&dev) != hipSuccess || hipDeviceGetAttribute(&cus, hipDeviceAttributeMultiprocessorCount, dev) != hipSuccess) { grid = -1; return; }
        if (hipFuncSetAttribute((const void*)fwd_kernel, hipFuncAttributeMaxDynamicSharedMemorySize, LDS_BYTES) != hipSuccess) { fprintf(stderr, "kernel_launch: hipFuncSetAttribute failed\n"); grid = -1; return; }
        if (hipOccupancyMaxActiveBlocksPerMultiprocessor(&per_cu, (const void*)fwd_kernel, NTHREADS, LDS_BYTES) != hipSuccess || per_cu < 1) fprintf(stderr, "kernel_launch: occupancy query says %d\n", per_cu);
        (void)hipGetLastError();
        grid = cus;
    }
    if (grid < 0) return;
    (void)hipMemsetAsync((char*)d_ws + WS_CTL, 0, CTL_ZERO_BYTES, stream);
    Args a{};
    for (int i = 0; i < 22; ++i) a.in[i] = d_in[i];
    a.out = (float*)d_out; a.ws = (unsigned char*)d_ws;
#ifdef PROBE_DUP
    a.ph_lo = 0; a.ph_hi = PROBE_DUP + 1; a.li = 0; hipLaunchKernelGGL(fwd_kernel, dim3(grid), dim3(NTHREADS), LDS_BYTES, stream, a);
    a.ph_lo = PROBE_DUP; a.ph_hi = NPHASES; a.li = 1; hipLaunchKernelGGL(fwd_kernel, dim3(grid), dim3(NTHREADS), LDS_BYTES, stream, a);
    return;
#endif
    if (N_LAUNCH_MODE == 1) { a.ph_lo = 0; a.ph_hi = NPHASES; hipLaunchKernelGGL(fwd_kernel, dim3(grid), dim3(NTHREADS), LDS_BYTES, stream, a); }
    else for (int p = 0; p < NPHASES; ++p) { if (p == 3) continue; a.ph_lo = p; a.ph_hi = p + 1; hipLaunchKernelGGL(fwd_kernel, dim3(grid), dim3(NTHREADS), LDS_BYTES, stream, a); }
}
```

```cpp
#include <hip/hip_runtime.h>
#include <cstdio>
#include <cstdint>

#ifndef Y_FP8
#define Y_FP8 1
#endif
#ifndef N_LAUNCH_MODE
#define N_LAUNCH_MODE 1
#endif
#ifndef NAIVE_GEMM
#define NAIVE_GEMM 0
#endif
#ifndef NAIVE_MIXER
#define NAIVE_MIXER 0
#endif

#define GAS __attribute__((address_space(1)))
#define LAS __attribute__((address_space(3)))
typedef unsigned short bf16;
typedef unsigned v4u __attribute__((ext_vector_type(4)));
typedef unsigned v2u __attribute__((ext_vector_type(2)));
typedef float f32x4 __attribute__((ext_vector_type(4)));
typedef float f32x2 __attribute__((ext_vector_type(2)));
typedef short bf16x8 __attribute__((ext_vector_type(8)));

constexpr int NB = 4, SEQ = 4096, T = NB * SEQ, D = 2048;
constexpr int GH = 8, GDK = 128, RH = 4, RDK = 256;
constexpr int NE = 32, TOPK = 4;
constexpr int INC = 8208, NPROJ = 8192, MODW = 6 * D;
constexpr int MAXROWS = T * TOPK + NE * 256;
constexpr float EPS = 1e-6f;
constexpr int NTHREADS = 512, NWAVES = 8;
constexpr int NPHASES = 12;

constexpr size_t MiB = 1u << 20;
constexpr size_t WS_CTL = 0, CTL_ZERO_BYTES = 2 * MiB;
constexpr size_t WS_MOD = 1 * MiB;
constexpr size_t WS_TOKE = 2 * MiB;
constexpr size_t WS_TOKG = WS_TOKE + 256 * 1024;
constexpr size_t WS_TOKP = WS_TOKG + 256 * 1024;
constexpr size_t WS_BCNT = WS_TOKP + 256 * 1024;
constexpr size_t WS_TILEE = WS_BCNT + 128 * 1024;
constexpr size_t WS_META = WS_TILEE + 4096;
constexpr size_t WS_RGATE = 3 * MiB;
constexpr size_t WS_RTOK = 3 * MiB + 512 * 1024;
constexpr size_t WS_BA = 4 * MiB;
constexpr size_t WS_WBAT = 5 * MiB;
constexpr size_t WS_WRT = 5 * MiB + 256 * 1024;
constexpr size_t WS_WIN = 8 * MiB;
constexpr size_t WS_WOUT = 40 * MiB;
constexpr size_t WS_W1 = 48 * MiB;
constexpr size_t WS_W2 = 560 * MiB;
constexpr size_t WS_H = 816 * MiB;
constexpr size_t WS_PROJ = 880 * MiB;
constexpr size_t WS_O = 1136 * MiB;
constexpr size_t WS_X1 = 1264 * MiB;
constexpr size_t WS_XS = 1392 * MiB;
constexpr size_t WS_ACT = 1680 * MiB;
constexpr size_t WS_Y = 1968 * MiB;
constexpr size_t WS_GIMG = 2256 * MiB;
constexpr size_t WS_GU = 2368 * MiB;
constexpr size_t WS_RIMG = 2432 * MiB;
constexpr size_t WS_RINNER = 2496 * MiB;
constexpr size_t WS_RVF = 2560 * MiB;
constexpr size_t WS_GCD = 2592 * MiB;
constexpr size_t WS_ROT = 2593 * MiB;
constexpr size_t WS_END = 2609 * MiB;
constexpr int GIMG_BYTES = 57344, RIMG_BYTES = 65536;
constexpr int CW_BAR = 4096;
constexpr int CW_CONVQ = 64;

constexpr int LDS_BYTES = 160 * 1024;
constexpr int MISC_OFF = LDS_BYTES - 256;

#define LDS_WAIT() asm volatile("s_waitcnt lgkmcnt(0)" ::: "memory")
#define VM_WAIT() asm volatile("s_waitcnt vmcnt(0)" ::: "memory")
typedef __bf16 bf16v2_t __attribute__((ext_vector_type(2)));
__device__ __forceinline__ unsigned cvt2(float lo, float hi) { const f32x2 v = {lo, hi}; return __builtin_bit_cast(unsigned, __builtin_convertvector(v, bf16v2_t)); }
__device__ __forceinline__ unsigned pk2(float lo, float hi) { return cvt2(lo, hi); }
__device__ __forceinline__ unsigned f2bf(float f) { return (unsigned)__builtin_bit_cast(unsigned short, (__bf16)f); }
__device__ __forceinline__ float bf2f(unsigned b) { return __uint_as_float(b << 16); }
__device__ __forceinline__ float bflo(unsigned w) { return __uint_as_float(w << 16); }
__device__ __forceinline__ float bfhi(unsigned w) { return __uint_as_float(w & 0xffff0000u); }
__device__ __forceinline__ float wave_sum(float v) {
#pragma unroll
    for (int o = 1; o < 64; o <<= 1) v += __shfl_xor(v, o);
    return v;
}
__device__ __forceinline__ void lds_inc(LAS int* p) { (void)__hip_atomic_fetch_add(p, 1, __ATOMIC_RELAXED, __HIP_MEMORY_SCOPE_WORKGROUP); }
__device__ __forceinline__ float siluf(float v) { return v * __builtin_amdgcn_rcpf(1.f + __expf(-v)); }
__device__ __forceinline__ float sigmoidf_(float v) { return __builtin_amdgcn_rcpf(1.f + __expf(-v)); }
__device__ __forceinline__ float softplusf_(float v) { return v > 20.f ? v : log1pf(expf(v)); }

#define XB_TMO      128
#define XB_XCNT(j)  (256  + 64 * (j))
#define XB_XSUB(j)  (1280 + 64 * (j))
#define XB_XGEN(j)  (2304 + 64 * (j))
#define XB_TOP      3328
#define XB_TOPGEN   3392
#define XCD_BAR_WORDS 3456
#define XB_SPIN_CAP (1u << 24)
__device__ __forceinline__ unsigned xb_ld(unsigned* p)              { return __hip_atomic_load(p, __ATOMIC_RELAXED, __HIP_MEMORY_SCOPE_AGENT); }
__device__ __forceinline__ unsigned xb_add(unsigned* p, unsigned v) { return __hip_atomic_fetch_add(p, v, __ATOMIC_RELAXED, __HIP_MEMORY_SCOPE_AGENT); }
__device__ __forceinline__ unsigned xb_xcc_id() { return (unsigned)__builtin_amdgcn_s_getreg((3 << 11) | 20) & 0xFu; }
#define XB_SPIN(cond, bar) do { unsigned _sp = 0; while (cond) { __builtin_amdgcn_s_sleep(1); \
    if ((++_sp & 255u) == 0u) { if (xb_ld(&(bar)[XB_TMO])) break; if (_sp > XB_SPIN_CAP) { atomicAdd(&(bar)[XB_TMO], 1u); break; } } } } while (0)
struct XcdBarrier { unsigned* bar; unsigned x; volatile LAS unsigned* st; };
__device__ __forceinline__ XcdBarrier xcd_barrier_post(unsigned* bar, volatile LAS unsigned* st) {
    XcdBarrier b; b.bar = bar; b.x = xb_xcc_id(); b.st = st;
    if (threadIdx.x == 0) (void)xb_add(&bar[XB_XCNT(b.x)], 1u);
    return b;
}
__device__ __forceinline__ void xcd_barrier_complete(unsigned* bar, unsigned x, unsigned& nloc, unsigned& nx) {
    const unsigned G = gridDim.x * gridDim.y * gridDim.z;
    unsigned sum, cnt, mine, sp = 0u;
    for (;;) {
        sum = 0u; cnt = 0u; mine = 0u;
#pragma unroll
        for (unsigned j = 0; j < 16; ++j) { const unsigned c = xb_ld(&bar[XB_XCNT(j)]); sum += c; cnt += (c > 0u) ? 1u : 0u; mine = (j == x) ? c : mine; }
        if (sum == G) break;
        __builtin_amdgcn_s_sleep(1);
        if ((++sp & 255u) == 0u) { if (xb_ld(&bar[XB_TMO])) break; if (sp > XB_SPIN_CAP) { atomicAdd(&bar[XB_TMO], 1u); break; } }
    }
    nloc = mine > 0u ? mine : 1u; nx = cnt > 0u ? cnt : 1u;
}
__device__ __forceinline__ void xcd_barrier(const XcdBarrier& b) {
    asm volatile("s_waitcnt vmcnt(0)" ::: "memory");
    __syncthreads();
    if (threadIdx.x == 0) {
        unsigned* bar = b.bar;
        __builtin_amdgcn_s_waitcnt(0);
        unsigned nloc = b.st[0], nx = b.st[1];
        if (nloc == 0u) { xcd_barrier_complete(bar, b.x, nloc, nx); b.st[0] = nloc; b.st[1] = nx; }
        const unsigned old = xb_add(&bar[XB_XSUB(b.x)], 1u);
        const unsigned gen = old / nloc;
        if (old + 1u == (gen + 1u) * nloc) {
            __builtin_amdgcn_fence(__ATOMIC_RELEASE, "agent");
            asm volatile("s_waitcnt vmcnt(0)" ::: "memory");
            const unsigned og = xb_add(&bar[XB_TOP], 1u);
            const unsigned tg = og / nx;
            if (og + 1u == (tg + 1u) * nx) xb_add(&bar[XB_TOPGEN], 1u);
            else XB_SPIN(xb_ld(&bar[XB_TOPGEN]) == tg, bar);
            __builtin_amdgcn_fence(__ATOMIC_ACQUIRE, "agent");
            xb_add(&bar[XB_XGEN(b.x)], 1u);
            asm volatile("s_waitcnt vmcnt(0)" ::: "memory");
        } else {
            XB_SPIN(xb_ld(&bar[XB_XGEN(b.x)]) == gen, bar);
            __builtin_amdgcn_fence(__ATOMIC_ACQUIRE, "agent");
            asm volatile("s_waitcnt vmcnt(0)" ::: "memory");
        }
    }
    __syncthreads();
}

struct Ctx {
    int vcu;
    LAS unsigned char* lds;
    int tid, lane, wave, G, bid;
    const float *x, *c_in; const int* positions;
    const float *ada_w, *ada_b, *norm1_g, *w_in, *conv_w, *a_log, *dt_bias, *gdn_norm_g, *ret_norm_g, *ret_norm_b, *w_out, *norm2_g, *w_router, *b_router, *w1, *b1, *w2, *b2, *final_g;
    float* out;
    unsigned* ctl; float* mod; int* tok_e; float* tok_g; int* tok_pos; int* blk_cnt; int* tile_e; int* meta; float* row_gate; int* row_tok;
    float* ba; float* wba_t; float* wr_t;
    bf16 *win_t, *wout_t, *H, *PROJ, *Y;
    unsigned char *w1_q, *w2_q, *H8, *XS8, *ACT8;
    float *O; bf16* X1; bf16* Ob;
    unsigned char *gimg, *rimg, *rvf; float *gu, *rinner, *gcd; f32x2* rot;
};

__device__ __forceinline__ void ph_mod(const Ctx& c) {
    LAS float* cond = (LAS float*)(c.lds);
    LAS float* red = (LAS float*)(c.lds + 32768);
    bool did = false;
    for (int u = c.bid; u < MODW / 64; u += c.G) {
        if (!did) { for (int i = c.tid; i < NB * D; i += NTHREADS) { const float v = c.c_in[i]; cond[i] = v / (1.f + expf(-v)); } __syncthreads(); did = true; }
        const int col = u * 64 + c.lane, kbase = c.wave * 256;
        float acc[4] = {0.f, 0.f, 0.f, 0.f};
        const float* wp = c.ada_w + (size_t)kbase * MODW + col;
#pragma unroll 16
        for (int k = 0; k < 256; ++k) {
            const float w = wp[(size_t)k * MODW];
#pragma unroll
            for (int b = 0; b < 4; ++b) acc[b] += cond[b * D + kbase + k] * w;
        }
#pragma unroll
        for (int b = 0; b < 4; ++b) red[(c.wave * 4 + b) * 64 + c.lane] = acc[b];
        __syncthreads();
        if (c.tid < 256) { const int b = c.tid >> 6, cc = c.tid & 63; float s = c.ada_b[u * 64 + cc];
#pragma unroll
            for (int w = 0; w < 8; ++w) s += red[(w * 4 + b) * 64 + cc];
            c.mod[b * MODW + u * 64 + cc] = s; }
        __syncthreads();
    }
}
__device__ __forceinline__ void transpose_item(const float* W, int ldw, int scol0, int k0, bf16* WT, size_t drow0, int ldk, LAS float* scr, int lane) {
#pragma unroll 8
    for (int i = 0; i < 32; ++i) { const int kk = 2 * i + (lane >> 5); scr[kk * 33 + (lane & 31)] = W[(size_t)(k0 + kk) * ldw + scol0 + (lane & 31)]; }
    LDS_WAIT(); asm volatile("" ::: "memory");
    const int cch = lane & 7;
#pragma unroll
    for (int j = 0; j < 4; ++j) { const int n = (lane >> 3) + 8 * j; const LAS float* s = scr + (8 * cch) * 33 + n;
        v4u o; o.x = pk2(s[0 * 33], s[1 * 33]); o.y = pk2(s[2 * 33], s[3 * 33]); o.z = pk2(s[4 * 33], s[5 * 33]); o.w = pk2(s[6 * 33], s[7 * 33]);
        *(GAS v4u*)(WT + (drow0 + n) * ldk + k0 + 8 * cch) = o; }
    LDS_WAIT(); asm volatile("" ::: "memory");
}
__device__ __forceinline__ unsigned pk4_fp8(float a, float b, float c2, float d) {
    a = fminf(fmaxf(a, -448.f), 448.f); b = fminf(fmaxf(b, -448.f), 448.f); c2 = fminf(fmaxf(c2, -448.f), 448.f); d = fminf(fmaxf(d, -448.f), 448.f);
    int w = 0; w = __builtin_amdgcn_cvt_pk_fp8_f32(a, b, w, false); w = __builtin_amdgcn_cvt_pk_fp8_f32(c2, d, w, true); return (unsigned)w;
}
__device__ __forceinline__ unsigned pk4_fp8_nc(float a, float b, float c2, float d) {
    int w = 0; w = __builtin_amdgcn_cvt_pk_fp8_f32(a, b, w, false); w = __builtin_amdgcn_cvt_pk_fp8_f32(c2, d, w, true); return (unsigned)w;
}
constexpr float W8_SCALE = 256.f;
__device__ __forceinline__ void transpose_item_f8(const float* W, int ldw, int scol0, int k0, unsigned char* WT, size_t drow0, int ldk, LAS float* scr, int lane) {
#pragma unroll 8
    for (int i = 0; i < 32; ++i) { const int kk = 2 * i + (lane >> 5); scr[kk * 33 + (lane & 31)] = W[(size_t)(k0 + kk) * ldw + scol0 + (lane & 31)]; }
    LDS_WAIT(); asm volatile("" ::: "memory");
    const int cch = lane & 7;
#pragma unroll
    for (int j = 0; j < 4; ++j) { const int n = (lane >> 3) + 8 * j; const LAS float* s = scr + (8 * cch) * 33 + n;
        v2u o; o.x = pk4_fp8(s[0 * 33] * W8_SCALE, s[1 * 33] * W8_SCALE, s[2 * 33] * W8_SCALE, s[3 * 33] * W8_SCALE); o.y = pk4_fp8(s[4 * 33] * W8_SCALE, s[5 * 33] * W8_SCALE, s[6 * 33] * W8_SCALE, s[7 * 33] * W8_SCALE);
        *(GAS v2u*)(WT + (drow0 + n) * ldk + k0 + 8 * cch) = o; }
    LDS_WAIT(); asm volatile("" ::: "memory");
}
__device__ __forceinline__ void f8item_addr(const Ctx& c, int r, const float*& W, int& ldw, int& scol, int& k0, unsigned char*& WT, size_t& drow0) {
    if (r < 32 * 32 * 128) { const int e = r >> 12, kb = (r >> 7) & 31, nb = r & 127, n0 = 32 * nb; scol = ((n0 >> 7) & 1) * 2048 + (n0 >> 8) * 128 + (n0 & 127);
        W = c.w1 + (size_t)e * D * 4096; ldw = 4096; k0 = 64 * kb; WT = c.w1_q; drow0 = (size_t)e * 4096 + n0; }
    else { r -= 32 * 32 * 128; const int e = r >> 11, kb = (r >> 6) & 31, nb = r & 63; scol = 32 * nb; W = c.w2 + (size_t)e * D * D; ldw = D; k0 = 64 * kb; WT = c.w2_q; drow0 = (size_t)e * D + 32 * nb; }
}
__device__ __forceinline__ void f8item_load(const float* W, int ldw, int scol, int k0, int lane, f32x4 (&rg)[8]) {
    const float* p = W + (size_t)(k0 + (lane >> 3)) * ldw + scol + 4 * (lane & 7);
#pragma unroll
    for (int i = 0; i < 8; ++i) rg[i] = *(const f32x4*)(p + (size_t)(8 * i) * ldw);
}
__device__ __forceinline__ void f8item_emit(const f32x4 (&rg)[8], unsigned char* WT, size_t drow0, int k0, LAS float* scr, int lane) {
#pragma unroll
    for (int i = 0; i < 8; ++i) { LAS float* d = scr + (8 * i + (lane >> 3)) * 33 + 4 * (lane & 7); d[0] = rg[i].x; d[1] = rg[i].y; d[2] = rg[i].z; d[3] = rg[i].w; }
    LDS_WAIT(); asm volatile("" ::: "memory");
    const int cch = lane & 7;
#pragma unroll
    for (int j = 0; j < 4; ++j) { const int n = (lane >> 3) + 8 * j; const LAS float* s = scr + (8 * cch) * 33 + n;
        v2u o; o.x = pk4_fp8(s[0 * 33] * W8_SCALE, s[1 * 33] * W8_SCALE, s[2 * 33] * W8_SCALE, s[3 * 33] * W8_SCALE); o.y = pk4_fp8(s[4 * 33] * W8_SCALE, s[5 * 33] * W8_SCALE, s[6 * 33] * W8_SCALE, s[7 * 33] * W8_SCALE);
        *(GAS v2u*)(WT + (drow0 + n) * D + k0 + 8 * cch) = o; }
    LDS_WAIT(); asm volatile("" ::: "memory");
}
constexpr int IT_WIN = 32 * 256, IT_WOUT = 32 * 64, IT_W1 = 32 * 32 * 128, IT_W2 = 32 * 32 * 64;
constexpr int IT_SMALL = IT_WIN + IT_WOUT, IT_ALL = IT_SMALL + IT_W1 + IT_W2;
constexpr int SCAN_UNITS = 64;
__device__ __forceinline__ void convert_items(const Ctx& c, int it0, int it1, int wk, int nwk, LAS unsigned char* scrbase) {
    LAS float* scr = (LAS float*)(scrbase + c.wave * 8704);
    for (int it = it0 + wk; it < it1; it += nwk) {
        int r = it;
        if (r < IT_WIN) { const int kb = r >> 8, nb = r & 255, n0 = 32 * nb; transpose_item(c.w_in, INC, n0 < 4096 ? n0 : n0 + 16, 64 * kb, c.win_t, n0, D, scr, c.lane); continue; }
        r -= IT_WIN;
        if (r < IT_WOUT) { const int kb = r >> 6, nb = r & 63; transpose_item(c.w_out, D, 32 * nb, 64 * kb, c.wout_t, 32 * nb, D, scr, c.lane); continue; }
        r -= IT_WOUT;
        if (r < IT_W1) { const int e = r >> 12, kb = (r >> 7) & 31, nb = r & 127, n0 = 32 * nb; const int scol = ((n0 >> 7) & 1) * 2048 + (n0 >> 8) * 128 + (n0 & 127);
            transpose_item_f8(c.w1 + (size_t)e * D * 4096, 4096, scol, 64 * kb, c.w1_q, (size_t)e * 4096 + n0, D, scr, c.lane); continue; }
        r -= IT_W1;
        { const int e = r >> 11, kb = (r >> 6) & 31, nb = r & 63; transpose_item_f8(c.w2 + (size_t)e * D * D, D, 32 * nb, 64 * kb, c.w2_q, (size_t)e * D + 32 * nb, D, scr, c.lane); }
    }
}
__device__ __forceinline__ void ph_prologue(const Ctx& c) {
    ph_mod(c);
    __syncthreads();
    for (int i = c.bid * NTHREADS + c.tid; i < 16 * D; i += c.G * NTHREADS) { const int k = i >> 4, j = i & 15; c.wba_t[j * D + k] = c.w_in[(size_t)k * INC + 4096 + j]; }
    for (int i = c.bid * NTHREADS + c.tid; i < 32 * D; i += c.G * NTHREADS) { const int k = i >> 5, e = i & 31; c.wr_t[e * D + k] = c.w_router[k * 32 + e]; }
    for (int i = c.bid * NTHREADS + c.tid; i < T * 128; i += c.G * NTHREADS) { const int t = i >> 7, j = i & 127;
        const float invf = exp2f(-(float)j * (13.287712379549449f / 127.f)); float sn, cs; sincosf((float)c.positions[t] * invf, &sn, &cs); c.rot[i] = (f32x2){cs, sn}; }
    convert_items(c, 0, c.G > SCAN_UNITS ? IT_SMALL : IT_ALL, c.bid * NWAVES + c.wave, c.G * NWAVES, c.lds);
}

__device__ __forceinline__ int tokens_per_block(int G);
__device__ __forceinline__ void ph_norm1(const Ctx& c) {
    constexpr int RSB = 2056;
    LAS bf16* hH = (LAS bf16*)c.lds;
    LAS bf16* hL = hH + 16 * RSB;
    LAS float* part = (LAS float*)(c.lds + 2 * 16 * RSB * 2);
    LAS float* GpL = part + 2048;
    LAS float* ShL = GpL + 2048;
    const int TPB = tokens_per_block(c.G), base = c.bid * TPB;
    const int lane = c.lane, w = c.wave, fi = lane & 15, kq = lane >> 4;
    if (base >= T) return;
    f32x4 xn[2][8];
    { const int m0 = base + 2 * w; const int mr = m0 < T ? m0 : 0;
#pragma unroll
      for (int r = 0; r < 2; ++r) { const float* xr = c.x + (size_t)(mr + r) * D + 8 * lane;
#pragma unroll
          for (int j = 0; j < 4; ++j) { xn[r][2 * j] = *(const f32x4*)(xr + 512 * j); xn[r][2 * j + 1] = *(const f32x4*)(xr + 512 * j + 4); } } }
    bf16x8 wbH[8], wbL[8];
    { const float* bp = c.wba_t + (size_t)fi * D + 256 * w + 8 * kq;
#pragma unroll
      for (int s2 = 0; s2 < 8; ++s2) { const f32x4 f0 = *(const f32x4*)(bp + 32 * s2), f1 = *(const f32x4*)(bp + 32 * s2 + 4);
          const unsigned h0 = cvt2(f0.x, f0.y), h1 = cvt2(f0.z, f0.w), h2 = cvt2(f1.x, f1.y), h3 = cvt2(f1.z, f1.w);
          const unsigned l0 = cvt2(f0.x - bflo(h0), f0.y - bfhi(h0)), l1 = cvt2(f0.z - bflo(h1), f0.w - bfhi(h1)), l2 = cvt2(f1.x - bflo(h2), f1.y - bfhi(h2)), l3 = cvt2(f1.z - bflo(h3), f1.w - bfhi(h3));
          wbH[s2] = __builtin_bit_cast(bf16x8, (v4u){h0, h1, h2, h3}); wbL[s2] = __builtin_bit_cast(bf16x8, (v4u){l0, l1, l2, l3}); } }
    int cbat = -1;
    for (int p0 = 0; p0 < TPB; p0 += 16) {
        if (base + p0 >= T) break;
        const int bat = (base + p0) >> 12;
        if (bat != cbat) {
            cbat = bat; __syncthreads();
            const float* mb = c.mod + bat * MODW; const int col = 4 * c.tid;
            const f32x4 g = *(const f32x4*)(c.norm1_g + col), sc = *(const f32x4*)(mb + D + col), sh = *(const f32x4*)(mb + col);
            *(LAS f32x4*)(GpL + col) = g * (1.f + sc); *(LAS f32x4*)(ShL + col) = sh;
            __syncthreads();
        }
        {
            const int m0 = base + p0 + 2 * w;
            const bool ok = m0 < T;
            const int mr = ok ? m0 : 0;
#pragma unroll
            for (int r = 0; r < 2; ++r) {
                float ss = 0.f;
#pragma unroll
                for (int j = 0; j < 8; ++j) ss += (xn[r][j].x * xn[r][j].x + xn[r][j].y * xn[r][j].y) + (xn[r][j].z * xn[r][j].z + xn[r][j].w * xn[r][j].w);
                const float rstd = rsqrtf(wave_sum(ss) * (1.f / D) + EPS);
                v4u* o8 = (v4u*)(c.H + (size_t)(mr + r) * D) + lane; const int lo = (2 * w + r) * RSB + 8 * lane;
#pragma unroll
                for (int j = 0; j < 4; ++j) { const int col = 8 * lane + 512 * j;
                    const f32x4 gp0 = *(const LAS f32x4*)(GpL + col), gp1 = *(const LAS f32x4*)(GpL + col + 4), sh0 = *(const LAS f32x4*)(ShL + col), sh1 = *(const LAS f32x4*)(ShL + col + 4);
                    const f32x4 v0 = (xn[r][2 * j] * rstd) * gp0 + sh0, v1 = (xn[r][2 * j + 1] * rstd) * gp1 + sh1;
                    v4u hw, lw; hw.x = cvt2(v0.x, v0.y); hw.y = cvt2(v0.z, v0.w); hw.z = cvt2(v1.x, v1.y); hw.w = cvt2(v1.z, v1.w);
                    lw.x = cvt2(v0.x - bflo(hw.x), v0.y - bfhi(hw.x)); lw.y = cvt2(v0.z - bflo(hw.y), v0.w - bfhi(hw.y)); lw.z = cvt2(v1.x - bflo(hw.z), v1.y - bfhi(hw.z)); lw.w = cvt2(v1.z - bflo(hw.w), v1.w - bfhi(hw.w));
                    if (ok) o8[64 * j] = hw;
                    *(LAS v4u*)(hH + lo + 512 * j) = hw; *(LAS v4u*)(hL + lo + 512 * j) = lw; }
            }
            const int m1 = m0 + 16;
            if (p0 + 16 < TPB && m1 < T) {
#pragma unroll
                for (int r = 0; r < 2; ++r) { const float* xr = c.x + (size_t)(m1 + r) * D + 8 * lane;
#pragma unroll
                    for (int j = 0; j < 4; ++j) { xn[r][2 * j] = *(const f32x4*)(xr + 512 * j); xn[r][2 * j + 1] = *(const f32x4*)(xr + 512 * j + 4); } } }
        }
        __syncthreads();
        {
            f32x4 aHH = {0.f, 0.f, 0.f, 0.f}, aHL = {0.f, 0.f, 0.f, 0.f}, aLH = {0.f, 0.f, 0.f, 0.f};
            const int ao = fi * RSB + 256 * w + 8 * kq;
#pragma unroll
            for (int s2 = 0; s2 < 8; ++s2) {
                const bf16x8 ah = *(const LAS bf16x8*)(hH + ao + 32 * s2), al = *(const LAS bf16x8*)(hL + ao + 32 * s2);
                aHH = __builtin_amdgcn_mfma_f32_16x16x32_bf16(ah, wbH[s2], aHH, 0, 0, 0); aHL = __builtin_amdgcn_mfma_f32_16x16x32_bf16(ah, wbL[s2], aHL, 0, 0, 0); aLH = __builtin_amdgcn_mfma_f32_16x16x32_bf16(al, wbH[s2], aLH, 0, 0, 0);
            }
            *(LAS f32x4*)(part + (w * 64 + lane) * 4) = aHH + (aHL + aLH);
        }
        __syncthreads();
        if (c.tid < 256) {
            const int i = c.tid >> 4, n = c.tid & 15; float sacc = 0.f;
            const LAS float* pp = part + ((i >> 2) * 16 + n) * 4 + (i & 3);
#pragma unroll
            for (int ww = 0; ww < 8; ++ww) sacc += pp[ww * 256];
            if (base + p0 + i < T) c.ba[(size_t)(base + p0 + i) * 16 + n] = sacc;
        }
    }
}

template <class ARow, class BRow, class Epi>
__device__ __forceinline__ void naive_gemm(const Ctx& c, int nMt, int nNt, int K, const ARow& arow, const BRow& brow, const Epi& epi) {
    LAS float* As = (LAS float*)c.lds;
    LAS float* Bs = As + 32 * 68;
    const int tid = c.tid, ty = tid >> 5, tx = tid & 31;
    for (int u = c.bid; u < nMt * nNt; u += c.G) {
        const int mt = u / nNt, nt = u % nNt;
        float acc[4][8];
#pragma unroll
        for (int r = 0; r < 4; ++r)
#pragma unroll
            for (int i = 0; i < 8; ++i) acc[r][i] = 0.f;
        for (int k0 = 0; k0 < K; k0 += 32) {
            if (tid < 256) { const int r = tid >> 2, kc = (tid & 3) * 8; const v4u w = *(const v4u*)(arow(mt * 64 + r) + k0 + kc);
                As[(kc + 0) * 68 + r] = bflo(w.x); As[(kc + 1) * 68 + r] = bfhi(w.x); As[(kc + 2) * 68 + r] = bflo(w.y); As[(kc + 3) * 68 + r] = bfhi(w.y);
                As[(kc + 4) * 68 + r] = bflo(w.z); As[(kc + 5) * 68 + r] = bfhi(w.z); As[(kc + 6) * 68 + r] = bflo(w.w); As[(kc + 7) * 68 + r] = bfhi(w.w); }
            { const int n = tid >> 1, kc = (tid & 1) * 16; const bf16* bp = brow(mt, nt * 256 + n) + k0 + kc; const v4u w0 = *(const v4u*)bp, w1 = *(const v4u*)(bp + 8);
                LAS float* d = Bs + kc * 260 + n;
                d[0 * 260] = bflo(w0.x); d[1 * 260] = bfhi(w0.x); d[2 * 260] = bflo(w0.y); d[3 * 260] = bfhi(w0.y); d[4 * 260] = bflo(w0.z); d[5 * 260] = bfhi(w0.z); d[6 * 260] = bflo(w0.w); d[7 * 260] = bfhi(w0.w);
                d[8 * 260] = bflo(w1.x); d[9 * 260] = bfhi(w1.x); d[10 * 260] = bflo(w1.y); d[11 * 260] = bfhi(w1.y); d[12 * 260] = bflo(w1.z); d[13 * 260] = bfhi(w1.z); d[14 * 260] = bflo(w1.w); d[15 * 260] = bfhi(w1.w); }
            __syncthreads();
#pragma unroll 4
            for (int kk = 0; kk < 32; ++kk) { const f32x4 a = *(const LAS f32x4*)(As + kk * 68 + 4 * ty); float bv[8];
#pragma unroll
                for (int i = 0; i < 8; ++i) bv[i] = Bs[kk * 260 + tx + 32 * i];
#pragma unroll
                for (int i = 0; i < 8; ++i) { acc[0][i] += a.x * bv[i]; acc[1][i] += a.y * bv[i]; acc[2][i] += a.z * bv[i]; acc[3][i] += a.w * bv[i]; } }
            __syncthreads();
        }
#pragma unroll
        for (int r = 0; r < 4; ++r) epi(mt * 64 + 4 * ty + r, nt * 256, tx, acc[r]);
    }
}

__device__ __forceinline__ void naive_gdn(const Ctx& c, int b, int h) {
    LAS float* sq = (LAS float*)c.lds;
    LAS float* red = sq + 384;
    LAS float* nrm = red + 512;
    const int tid = c.tid, v = tid & 127, dq = tid >> 7;
    float S[32];
#pragma unroll
    for (int i = 0; i < 32; ++i) S[i] = 0.f;
    const float A = expf(c.a_log[h]), dtb = c.dt_bias[h];
    for (int t = 0; t < SEQ; ++t) {
        const size_t row = (size_t)b * SEQ + t;
        if (tid < 384) { const int mat = tid >> 7, ch = tid & 127, col = mat * 1024 + h * 128 + ch; float a = 0.f;
#pragma unroll
            for (int i = 0; i < 4; ++i) { const int tt = t - 3 + i; if (tt >= 0) a += c.conv_w[i * 3072 + col] * bf2f(c.PROJ[((size_t)b * SEQ + tt) * NPROJ + col]); }
            sq[tid] = siluf(a); }
        __syncthreads();
        if (c.wave < 2) { const float a0 = sq[c.wave * 128 + c.lane], a1 = sq[c.wave * 128 + 64 + c.lane]; const float s = wave_sum(a0 * a0 + a1 * a1); if (c.lane == 0) nrm[c.wave] = s; }
        __syncthreads();
        const float rq = rsqrtf(nrm[0] + EPS) * 0.08838834764831845f, rk = rsqrtf(nrm[1] + EPS);
        const float beta = sigmoidf_(c.ba[row * 16 + h]), gs = -A * softplusf_(c.ba[row * 16 + 8 + h] + dtb), a = expf(gs);
        float p = 0.f;
#pragma unroll
        for (int i = 0; i < 32; ++i) p += sq[128 + 32 * dq + i] * rk * S[i];
        red[dq * 128 + v] = p;
        __syncthreads();
        const float kS = (red[v] + red[128 + v]) + (red[256 + v] + red[384 + v]);
        const float vv = sq[256 + v];
        __syncthreads();
        float po = 0.f;
#pragma unroll
        for (int i = 0; i < 32; ++i) { const float kd = sq[128 + 32 * dq + i] * rk; S[i] = a * (S[i] - beta * kd * kS) + beta * kd * vv; po += sq[32 * dq + i] * rq * S[i]; }
        red[dq * 128 + v] = po;
        __syncthreads();
        if (dq == 0) c.O[row * D + h * 128 + v] = (red[v] + red[128 + v]) + (red[256 + v] + red[384 + v]);
        __syncthreads();
    }
}
__device__ __forceinline__ void naive_ret(const Ctx& c, int b, int h, int vh) {
    LAS float* sq = (LAS float*)c.lds;
    LAS float* red = sq + 640;
    const int tid = c.tid, v = tid & 127, dq = tid >> 7;
    float S[64];
#pragma unroll
    for (int i = 0; i < 64; ++i) S[i] = 0.f;
    const float gamma = 1.f - exp2f(-5.f - (float)h);
    for (int t = 0; t < SEQ; ++t) {
        const size_t row = (size_t)b * SEQ + t;
        if (tid < 256) { const int mat = tid >> 7, i = tid & 127; const int colb = 4096 + mat * 1024 + h * 256;
            const float x1 = bf2f(c.PROJ[row * NPROJ + colb + i]), x2 = bf2f(c.PROJ[row * NPROJ + colb + 128 + i]);
            const float invf = powf(10000.f, -(float)i / 127.f), ang = (float)c.positions[row] * invf; const float cs = cosf(ang), sn = sinf(ang);
            const float sc = mat ? 0.0625f : 1.f;
            sq[mat * 256 + i] = (x1 * cs - x2 * sn) * sc; sq[mat * 256 + 128 + i] = (x2 * cs + x1 * sn) * sc; }
        else if (tid < 384) { const int i = tid - 256; sq[512 + i] = bf2f(c.PROJ[row * NPROJ + 6144 + h * 256 + vh * 128 + i]); }
        __syncthreads();
        const float vv = sq[512 + v]; float po = 0.f;
#pragma unroll
        for (int i = 0; i < 64; ++i) { S[i] = gamma * S[i] + sq[256 + 64 * dq + i] * vv; po += sq[64 * dq + i] * S[i]; }
        red[dq * 128 + v] = po;
        __syncthreads();
        if (dq == 0) c.O[row * D + 1024 + h * 256 + vh * 128 + v] = (red[v] + red[128 + v]) + (red[256 + v] + red[384 + v]);
        __syncthreads();
    }
}
__device__ __forceinline__ void ph_mixer_naive(const Ctx& c) {
    for (int u = c.bid; u < 64; u += c.G) {
        if (u < 32) naive_gdn(c, u >> 3, u & 7);
        else { const int r = u - 32; naive_ret(c, r >> 3, (r >> 1) & 3, r & 1); }
    }
}

__device__ __forceinline__ void ph_gatenorm(const Ctx& c) {
    const int gw = c.bid * NWAVES + c.wave, NGW = c.G * NWAVES;
    v4u ow[4], zw[4];
    auto fetch = [&](int m, v4u (&o)[4], v4u (&z)[4]) {
        const v4u* orow = (const v4u*)(c.Ob + (size_t)m * D) + c.lane; const bf16* prow = c.PROJ + (size_t)m * NPROJ + 8 * c.lane;
#pragma unroll
        for (int j = 0; j < 4; ++j) { o[j] = orow[64 * j]; z[j] = *(const v4u*)(prow + (j < 2 ? 3072 + 512 * j : 7168 + 512 * (j - 2))); } };
    if (gw < T) fetch(gw, ow, zw);
    for (int m = gw; m < T; m += NGW) {
        v4u on[4], zn[4];
        const bool more = m + NGW < T;
        if (more) fetch(m + NGW, on, zn);
        v4u* o8 = (v4u*)(c.H + (size_t)m * D) + c.lane;
#pragma unroll
        for (int j = 0; j < 4; ++j) {
            const int col = 8 * c.lane + 512 * j;
            const f32x4 oa = {bflo(ow[j].x), bfhi(ow[j].x), bflo(ow[j].y), bfhi(ow[j].y)}, ob = {bflo(ow[j].z), bfhi(ow[j].z), bflo(ow[j].w), bfhi(ow[j].w)};
            const f32x4 za = {bflo(zw[j].x), bfhi(zw[j].x), bflo(zw[j].y), bfhi(zw[j].y)}, zb = {bflo(zw[j].z), bfhi(zw[j].z), bflo(zw[j].w), bfhi(zw[j].w)};
            f32x4 ra, rb;
            if (j < 2) {
                float ss = ((oa.x * oa.x + oa.y * oa.y) + (oa.z * oa.z + oa.w * oa.w)) + ((ob.x * ob.x + ob.y * ob.y) + (ob.z * ob.z + ob.w * ob.w));
#pragma unroll
                for (int s2 = 1; s2 < 16; s2 <<= 1) ss += __shfl_xor(ss, s2);
                const float rstd = rsqrtf(ss * (1.f / 128.f) + EPS);
                const f32x4 ga = *(const f32x4*)(c.gdn_norm_g + (col & 127)), gb = *(const f32x4*)(c.gdn_norm_g + (col & 127) + 4);
                ra.x = oa.x * rstd * ga.x * siluf(za.x); ra.y = oa.y * rstd * ga.y * siluf(za.y); ra.z = oa.z * rstd * ga.z * siluf(za.z); ra.w = oa.w * rstd * ga.w * siluf(za.w);
                rb.x = ob.x * rstd * gb.x * siluf(zb.x); rb.y = ob.y * rstd * gb.y * siluf(zb.y); rb.z = ob.z * rstd * gb.z * siluf(zb.z); rb.w = ob.w * rstd * gb.w * siluf(zb.w);
            } else {
                float sm = ((oa.x + oa.y) + (oa.z + oa.w)) + ((ob.x + ob.y) + (ob.z + ob.w));
#pragma unroll
                for (int s2 = 1; s2 < 32; s2 <<= 1) sm += __shfl_xor(sm, s2);
                const float mu = sm * (1.f / 256.f);
                const f32x4 da = oa - mu, db = ob - mu;
                float vs = ((da.x * da.x + da.y * da.y) + (da.z * da.z + da.w * da.w)) + ((db.x * db.x + db.y * db.y) + (db.z * db.z + db.w * db.w));
#pragma unroll
                for (int s2 = 1; s2 < 32; s2 <<= 1) vs += __shfl_xor(vs, s2);
                const float rstd = rsqrtf(vs * (1.f / 256.f) + EPS);
                const int cc = col - 1024;
                const f32x4 ga = *(const f32x4*)(c.ret_norm_g + cc), gb = *(const f32x4*)(c.ret_norm_g + cc + 4), ba = *(const f32x4*)(c.ret_norm_b + cc), bb = *(const f32x4*)(c.ret_norm_b + cc + 4);
                ra.x = (da.x * rstd * ga.x + ba.x) * siluf(za.x); ra.y = (da.y * rstd * ga.y + ba.y) * siluf(za.y); ra.z = (da.z * rstd * ga.z + ba.z) * siluf(za.z); ra.w = (da.w * rstd * ga.w + ba.w) * siluf(za.w);
                rb.x = (db.x * rstd * gb.x + bb.x) * siluf(zb.x); rb.y = (db.y * rstd * gb.y + bb.y) * siluf(zb.y); rb.z = (db.z * rstd * gb.z + bb.z) * siluf(zb.z); rb.w = (db.w * rstd * gb.w + bb.w) * siluf(zb.w);
            }
            v4u w; w.x = pk2(ra.x, ra.y); w.y = pk2(ra.z, ra.w); w.z = pk2(rb.x, rb.y); w.w = pk2(rb.z, rb.w); o8[64 * j] = w;
        }
        if (more) {
#pragma unroll
            for (int j = 0; j < 4; ++j) { ow[j] = on[j]; zw[j] = zn[j]; } }
    }
}

__device__ __forceinline__ int tokens_per_block(int G) { return (((T + G - 1) / G) + 15) & ~15; }
__device__ __forceinline__ void ph_router(const Ctx& c) {
    constexpr int RSB = 2056;
    LAS bf16* hH = (LAS bf16*)c.lds;
    LAS bf16* hL = hH + 16 * RSB;
    LAS float* part = (LAS float*)(c.lds + 2 * 16 * RSB * 2);
    LAS float* GpL = part + 2048;
    LAS float* ShL = GpL + 2048;
    LAS int* hist = (LAS int*)(ShL + 2048);
    if (c.tid < 32) hist[c.tid] = 0;
    const int TPB = tokens_per_block(c.G), base = c.bid * TPB;
    const int lane = c.lane, w = c.wave, fi = lane & 15, kq = lane >> 4, ks = w >> 1, nt = w & 1;
    if (base >= T) { __syncthreads(); if (c.tid < 32) c.blk_cnt[c.bid * 32 + c.tid] = 0; return; }
    v2u xn[2][8];
    { const int m0 = base + 2 * w; const int mr = m0 < T ? m0 : 0;
#pragma unroll
      for (int r = 0; r < 2; ++r) { const v2u* xr = (const v2u*)(c.X1 + (size_t)(mr + r) * D) + lane;
#pragma unroll
          for (int j = 0; j < 8; ++j) xn[r][j] = xr[64 * j]; } }
    const float brt = c.b_router[c.tid & 31];
    bf16x8 wrH[16], wrL[16];
    { const float* bp = c.wr_t + (size_t)(16 * nt + fi) * D + 512 * ks + 8 * kq;
#pragma unroll
      for (int s2 = 0; s2 < 16; ++s2) { const f32x4 f0 = *(const f32x4*)(bp + 32 * s2), f1 = *(const f32x4*)(bp + 32 * s2 + 4);
          const unsigned h0 = cvt2(f0.x, f0.y), h1 = cvt2(f0.z, f0.w), h2 = cvt2(f1.x, f1.y), h3 = cvt2(f1.z, f1.w);
          const unsigned l0 = cvt2(f0.x - bflo(h0), f0.y - bfhi(h0)), l1 = cvt2(f0.z - bflo(h1), f0.w - bfhi(h1)), l2 = cvt2(f1.x - bflo(h2), f1.y - bfhi(h2)), l3 = cvt2(f1.z - bflo(h3), f1.w - bfhi(h3));
          wrH[s2] = __builtin_bit_cast(bf16x8, (v4u){h0, h1, h2, h3}); wrL[s2] = __builtin_bit_cast(bf16x8, (v4u){l0, l1, l2, l3}); } }
    int cbat = -1;
    for (int p0 = 0; p0 < TPB; p0 += 16) {
        if (base + p0 >= T) break;
        const int bat = (base + p0) >> 12;
        if (bat != cbat) {
            cbat = bat; __syncthreads();
            const float* mb = c.mod + bat * MODW; const int col = 4 * c.tid;
            const f32x4 g = *(const f32x4*)(c.norm2_g + col), sc = *(const f32x4*)(mb + 4 * D + col), sh = *(const f32x4*)(mb + 3 * D + col);
            *(LAS f32x4*)(GpL + col) = g * (1.f + sc); *(LAS f32x4*)(ShL + col) = sh;
            __syncthreads();
        }
        {
            const int m0 = base + p0 + 2 * w;
            const bool ok = m0 < T;
            const int mr = ok ? m0 : 0;
#pragma unroll
            for (int r = 0; r < 2; ++r) {
                f32x4 h[8]; float ss = 0.f;
#pragma unroll
                for (int j = 0; j < 8; ++j) { h[j] = (f32x4){bflo(xn[r][j].x), bfhi(xn[r][j].x), bflo(xn[r][j].y), bfhi(xn[r][j].y)};
                    ss += (h[j].x * h[j].x + h[j].y * h[j].y) + (h[j].z * h[j].z + h[j].w * h[j].w); }
                const float rstd = rsqrtf(wave_sum(ss) * (1.f / D) + EPS);
                unsigned* o4 = (unsigned*)(c.H8 + (size_t)(mr + r) * D) + lane; const int lo = (2 * w + r) * RSB + 4 * lane;
#pragma unroll
                for (int j = 0; j < 8; ++j) { const f32x4 gp = *(const LAS f32x4*)(GpL + 4 * lane + 256 * j), sh = *(const LAS f32x4*)(ShL + 4 * lane + 256 * j);
                    const f32x4 v = (h[j] * rstd) * gp + sh;
                    if (ok) o4[64 * j] = pk4_fp8(v.x, v.y, v.z, v.w);
                    v2u hw, lw; hw.x = cvt2(v.x, v.y); hw.y = cvt2(v.z, v.w);
                    lw.x = cvt2(v.x - bflo(hw.x), v.y - bfhi(hw.x)); lw.y = cvt2(v.z - bflo(hw.y), v.w - bfhi(hw.y));
                    *(LAS v2u*)(hH + lo + 256 * j) = hw; *(LAS v2u*)(hL + lo + 256 * j) = lw; }
            }
            const int m1 = m0 + 16;
            if (p0 + 16 < TPB && m1 < T) {
#pragma unroll
                for (int r = 0; r < 2; ++r) { const v2u* xr = (const v2u*)(c.X1 + (size_t)(m1 + r) * D) + lane;
#pragma unroll
                    for (int j = 0; j < 8; ++j) xn[r][j] = xr[64 * j]; } }
        }
        __syncthreads();
        {
            f32x4 aHH = {0.f, 0.f, 0.f, 0.f}, aHL = {0.f, 0.f, 0.f, 0.f}, aLH = {0.f, 0.f, 0.f, 0.f};
            const int ao = fi * RSB + 512 * ks + 8 * kq;
#pragma unroll
            for (int s2 = 0; s2 < 16; ++s2) {
                const bf16x8 ah = *(const LAS bf16x8*)(hH + ao + 32 * s2), al = *(const LAS bf16x8*)(hL + ao + 32 * s2);
                aHH = __builtin_amdgcn_mfma_f32_16x16x32_bf16(ah, wrH[s2], aHH, 0, 0, 0); aHL = __builtin_amdgcn_mfma_f32_16x16x32_bf16(ah, wrL[s2], aHL, 0, 0, 0); aLH = __builtin_amdgcn_mfma_f32_16x16x32_bf16(al, wrH[s2], aLH, 0, 0, 0);
            }
            *(LAS f32x4*)(part + ((ks * 2 + nt) * 64 + lane) * 4) = aHH + (aHL + aLH);
        }
        __syncthreads();
        {
            const int i = c.tid >> 5, e_me = c.tid & 31, m = base + p0 + i;
            float val = brt;
            const LAS float* pp = part + (((e_me >> 4) * 64) + ((i >> 2) * 16 + (e_me & 15))) * 4 + (i & 3);
#pragma unroll
            for (int ww = 0; ww < 4; ++ww) val += pp[ww * 2 * 64 * 4];
            float selv[4]; int seli[4];
#pragma unroll
            for (int k = 0; k < 4; ++k) {
                float mx = val; int idx = e_me;
#pragma unroll
                for (int off = 16; off >= 1; off >>= 1) { const float om = __shfl_xor(mx, off); const int oi = __shfl_xor(idx, off); if (om > mx || (om == mx && oi < idx)) { mx = om; idx = oi; } }
                selv[k] = mx; seli[k] = idx; if (e_me == idx) val = -INFINITY;
            }
            const float e1 = expf(selv[1] - selv[0]), e2 = expf(selv[2] - selv[0]), e3 = expf(selv[3] - selv[0]); const float inv = 1.f / (1.f + e1 + e2 + e3);
            if (e_me == 0 && m < T) {
                c.tok_e[m * 4 + 0] = seli[0]; c.tok_e[m * 4 + 1] = seli[1]; c.tok_e[m * 4 + 2] = seli[2]; c.tok_e[m * 4 + 3] = seli[3];
                c.tok_g[m * 4 + 0] = inv; c.tok_g[m * 4 + 1] = e1 * inv; c.tok_g[m * 4 + 2] = e2 * inv; c.tok_g[m * 4 + 3] = e3 * inv;
                lds_inc(&hist[seli[0]]); lds_inc(&hist[seli[1]]); lds_inc(&hist[seli[2]]); lds_inc(&hist[seli[3]]); }
        }
    }
    __syncthreads();
    if (c.tid < 32) c.blk_cnt[c.bid * 32 + c.tid] = hist[c.tid];
}

__device__ __forceinline__ void ph_route2(const Ctx& c) {
    LAS int* part_all = (LAS int*)c.lds;
    LAS int* part_bef = part_all + 512;
    LAS int* tot = part_bef + 512;
    LAS int* bas = tot + 32;
    LAS int* pst = bas + 32;
    LAS int* ent = pst + 64;
    const int TPB = tokens_per_block(c.G), base = c.bid * TPB, nent = TPB * 4;
    LAS int* posl = ent + nent;
    { const int e = c.tid & 31, part = c.tid >> 5; int sa = 0, sb = 0;
      for (int bb = part; bb < c.G; bb += 16) { const int v = c.blk_cnt[bb * 32 + e]; sa += v; if (bb < c.bid) sb += v; }
      part_all[part * 32 + e] = sa; part_bef[part * 32 + e] = sb; }
    __syncthreads();
    if (c.tid < 32) { int sa = 0, sb = 0;
#pragma unroll
        for (int p = 0; p < 16; ++p) { sa += part_all[p * 32 + c.tid]; sb += part_bef[p * 32 + c.tid]; }
        tot[c.tid] = sa; bas[c.tid] = sb; }
    __syncthreads();
    if (c.tid == 0) { int p = 0; for (int e = 0; e < 32; ++e) { pst[e] = p; p += (tot[e] + 255) & ~255; } pst[32] = p; }
    for (int i = c.tid; i < nent; i += NTHREADS) { const int tok = base + (i >> 2); ent[i] = tok < T ? c.tok_e[tok * 4 + (i & 3)] : -1; }
    __syncthreads();
    for (int i = c.tid; i < nent; i += NTHREADS) {
        const int e = ent[i]; int pos = -1;
        if (e >= 0) { int rank = 0; for (int j = 0; j < i; ++j) rank += (ent[j] == e) ? 1 : 0;
            pos = pst[e] + bas[e] + rank; const int tok = base + (i >> 2);
            c.tok_pos[tok * 4 + (i & 3)] = pos; c.row_gate[pos] = c.tok_g[tok * 4 + (i & 3)]; c.row_tok[pos] = tok; }
        posl[i] = pos;
    }
    __syncthreads();
    for (int i0 = 4 * c.wave; i0 < nent; i0 += 4 * NWAVES) {
        v4u v[4][2]; int ps[4];
#pragma unroll
        for (int k = 0; k < 4; ++k) { const int i = i0 + k; ps[k] = (i < nent) ? posl[i] : -1; const int tok = base + (i >> 2);
            const v4u* src = (const v4u*)(c.H8 + (size_t)(ps[k] >= 0 ? tok : 0) * D) + c.lane; v[k][0] = src[0]; v[k][1] = src[64]; }
#pragma unroll
        for (int k = 0; k < 4; ++k) if (ps[k] >= 0) { v4u* dst = (v4u*)(c.XS8 + (size_t)ps[k] * D) + c.lane; dst[0] = v[k][0]; dst[64] = v[k][1]; }
    }
    if (c.bid == 0) {
        const int nmt = pst[32] >> 8;
        for (int mt = c.tid; mt < nmt; mt += NTHREADS) { int e = 0; while (e < 31 && pst[e + 1] <= mt * 256) ++e; c.tile_e[mt] = e; }
        if (c.tid == 0) c.meta[0] = nmt;
    }
}

__device__ __forceinline__ void ph_final(const Ctx& c) {
    const int gw = c.bid * NWAVES + c.wave, NGW = c.G * NWAVES;
    for (int m = gw; m < T; m += NGW) {
        const int b = m >> 12;
        const float* gt2 = c.mod + b * MODW + 5 * D;
        const v4u* xr = (const v4u*)(c.X1 + (size_t)m * D) + c.lane;
        int pos[4]; float gk[4];
#pragma unroll
        for (int k = 0; k < 4; ++k) { pos[k] = c.tok_pos[m * 4 + k]; gk[k] = c.tok_g[m * 4 + k]; }
        f32x4 v[8]; float ss = 0.f;
#pragma unroll
        for (int j = 0; j < 4; ++j) {
            const int col = 8 * c.lane + 512 * j; f32x4 y0 = {0.f, 0.f, 0.f, 0.f}, y1 = {0.f, 0.f, 0.f, 0.f};
#pragma unroll
            for (int k = 0; k < 4; ++k) {
                if (Y_FP8 && !NAIVE_GEMM) { const v2u w = *((const v2u*)((const unsigned char*)c.Y + (size_t)pos[k] * D) + c.lane + 64 * j);
                    const f32x2 a = __builtin_amdgcn_cvt_pk_f32_fp8((int)w.x, false), b2 = __builtin_amdgcn_cvt_pk_f32_fp8((int)w.x, true), c2 = __builtin_amdgcn_cvt_pk_f32_fp8((int)w.y, false), d2 = __builtin_amdgcn_cvt_pk_f32_fp8((int)w.y, true);
                    y0.x += a.x * gk[k]; y0.y += a.y * gk[k]; y0.z += b2.x * gk[k]; y0.w += b2.y * gk[k]; y1.x += c2.x * gk[k]; y1.y += c2.y * gk[k]; y1.z += d2.x * gk[k]; y1.w += d2.y * gk[k]; }
                else { const v4u w = *((const v4u*)(c.Y + (size_t)pos[k] * D) + c.lane + 64 * j);
                    y0.x += bflo(w.x); y0.y += bfhi(w.x); y0.z += bflo(w.y); y0.w += bfhi(w.y); y1.x += bflo(w.z); y1.y += bfhi(w.z); y1.z += bflo(w.w); y1.w += bfhi(w.w); } }
            const float ysc = (Y_FP8 && !NAIVE_GEMM) ? 0.125f : 1.f;
            const f32x4 g0 = *(const f32x4*)(gt2 + col) * ysc, g1 = *(const f32x4*)(gt2 + col + 4) * ysc;
            const v4u xw = xr[64 * j]; const f32x4 x0 = {bflo(xw.x), bfhi(xw.x), bflo(xw.y), bfhi(xw.y)}, x1 = {bflo(xw.z), bfhi(xw.z), bflo(xw.w), bfhi(xw.w)};
            v[2 * j] = x0 + g0 * y0; v[2 * j + 1] = x1 + g1 * y1;
            ss += ((v[2 * j].x * v[2 * j].x + v[2 * j].y * v[2 * j].y) + (v[2 * j].z * v[2 * j].z + v[2 * j].w * v[2 * j].w))
                + ((v[2 * j + 1].x * v[2 * j + 1].x + v[2 * j + 1].y * v[2 * j + 1].y) + (v[2 * j + 1].z * v[2 * j + 1].z + v[2 * j + 1].w * v[2 * j + 1].w));
        }
        const float rstd = rsqrtf(wave_sum(ss) * (1.f / D) + EPS);
        float* orow = c.out + (size_t)m * D + 8 * c.lane;
#pragma unroll
        for (int j = 0; j < 4; ++j) { const f32x4 g0 = *(const f32x4*)(c.final_g + 8 * c.lane + 512 * j), g1 = *(const f32x4*)(c.final_g + 8 * c.lane + 512 * j + 4);
            *(f32x4*)(orow + 512 * j) = v[2 * j] * rstd * g0; *(f32x4*)(orow + 512 * j + 4) = v[2 * j + 1] * rstd * g1; }
    }
}

struct ARowDense { const bf16* A; __device__ __forceinline__ const bf16* operator()(int row) const { return A + (size_t)row * D; } };
struct BRowDense { const bf16* Bt; __device__ __forceinline__ const bf16* operator()(int, int n) const { return Bt + (size_t)n * D; } };
struct BRowExpert { const bf16* Bt; const int* tile_e; int N; __device__ __forceinline__ const bf16* operator()(int mt64, int n) const { return Bt + ((size_t)tile_e[mt64 >> 2] * N + n) * D; } };
struct NEpiProj { bf16* O; __device__ __forceinline__ void operator()(int row, int cb, int tx, const float (&v)[8]) const {
#pragma unroll
        for (int i = 0; i < 8; ++i) O[(size_t)row * NPROJ + cb + tx + 32 * i] = (bf16)f2bf(v[i]); } };
struct NEpiResid { const float* x; const float* mod; bf16* X1; __device__ __forceinline__ void operator()(int row, int cb, int tx, const float (&v)[8]) const {
        const float* gt1 = mod + (row >> 12) * MODW + 2 * D;
#pragma unroll
        for (int i = 0; i < 8; ++i) { const int n = cb + tx + 32 * i; X1[(size_t)row * D + n] = (bf16)f2bf(x[(size_t)row * D + n] + gt1[n] * v[i]); } } };
__device__ __forceinline__ float swiglu(float g, float l) { g = fminf(g, 7.f); l = __builtin_amdgcn_fmed3f(l, -7.f, 7.f); return (g * __builtin_amdgcn_rcpf(1.f + __builtin_amdgcn_exp2f(-2.4554669595930156f * g))) * (l + 1.f); }
struct NEpiUp { bf16* ACT; const float* b1; const int* tile_e; __device__ __forceinline__ void operator()(int row, int cb, int tx, const float (&v)[8]) const {
        const int e = tile_e[row >> 8];
#pragma unroll
        for (int i = 0; i < 4; ++i) { const int f = (cb >> 8) * 128 + tx + 32 * i; const float g = v[i] + b1[e * 4096 + f], l = v[i + 4] + b1[e * 4096 + 2048 + f]; ACT[(size_t)row * D + f] = (bf16)f2bf(swiglu(g, l)); } } };
struct NEpiDown { bf16* Y; const float* b2; const int* tile_e; const float* row_gate; __device__ __forceinline__ void operator()(int row, int cb, int tx, const float (&v)[8]) const {
        const int e = tile_e[row >> 8]; const float gt = row_gate[row];
#pragma unroll
        for (int i = 0; i < 8; ++i) { const int n = cb + tx + 32 * i; Y[(size_t)row * D + n] = (bf16)f2bf((v[i] + b2[e * D + n]) * gt); } } };

namespace pg8 {
constexpr int BM = 256, BK = 64, HALF = 128, HTB = HALF * BK * 2, STAGE_BYTES = 8 * HTB, NXCD = 8, WGM = 4;
constexpr int K = D;
__host__ __device__ __forceinline__ int lds_byte(int r, int c) { const int t = r >> 3, r8 = r & 7, slot = ((c >> 3) & 7) ^ (2 * (r8 >> 1)); return t * 1024 + r8 * 128 + slot * 16; }
__host__ __device__ __forceinline__ void stage_rc(int b, int& R, int& C) { const int t = b / 1024, l = (b % 1024) / 16, r8 = l >> 3, slot = l & 7; R = 8 * t + r8; C = (slot ^ (2 * (r8 >> 1))) * 8; }
__host__ __device__ __forceinline__ int perm32(int rho) { const int n = rho >> 4, i = rho & 15; return 8 * (i >> 2) + 4 * n + (i & 3); }
struct Unit { int pm, pn; };
struct Sched {
    const void* A; const void* Bt; const int* tile_e; int N; int nM, nN, nwg, G, c; size_t rb;
    __device__ void init(const void* A_, const void* Bt_, const int* te, int nM_, int N_, int G_, int c_, size_t rb_) { A = A_; Bt = Bt_; tile_e = te; N = N_; nM = nM_; nN = N_ / BM; nwg = nM * nN; G = G_; c = c_; rb = rb_; }
    __device__ __forceinline__ bool next(int i, Unit& u) const {
        const long L = (long)i * G + c; if (L >= nwg) return false;
        int wgid = (int)L; { const int q = nwg / NXCD, r = nwg % NXCD, xcd = wgid % NXCD, off = wgid / NXCD; wgid = (xcd < r ? xcd * (q + 1) : r * (q + 1) + (xcd - r) * q) + off; }
        const int nig = WGM * nN, gid = wgid / nig, fm = gid * WGM, gsz = (nM - fm) < WGM ? (nM - fm) : WGM;
        u.pm = fm + ((wgid % nig) % gsz); u.pn = (wgid % nig) / gsz; return true;
    }
    __device__ __forceinline__ const char* a_base(const Unit& u) const { return (const char*)A + (size_t)u.pm * ((size_t)BM * rb); }
    __device__ __forceinline__ const char* b_base(const Unit& u) const { const size_t e = tile_e ? (size_t)__builtin_amdgcn_readfirstlane(tile_e[u.pm]) : 0; return (const char*)Bt + (e * N + (size_t)u.pn * BM) * rb; }
};
__device__ __forceinline__ unsigned cvt_pk_bf16(float lo, float hi) { unsigned r; asm volatile("v_cvt_pk_bf16_f32 %0, %1, %2" : "=v"(r) : "v"(lo), "v"(hi)); return r; }
struct EpiProj {
    static constexpr bool PERM = true;
    bf16* O; int ldc;
    __device__ __forceinline__ void operator()(const f32x4 (&acc)[2][2][4][2], const Unit& u, int wr, int wc, int fr, int fq) const {
        const int row0 = u.pm * BM + wr * 64 + fr, col0 = u.pn * BM + wc * 32 + 8 * fq;
#pragma unroll
        for (int ai = 0; ai < 2; ++ai)
#pragma unroll
            for (int m = 0; m < 4; ++m) { bf16* rowp = O + (size_t)(row0 + ai * HALF + m * 16) * ldc + col0;
#pragma unroll
                for (int bj = 0; bj < 2; ++bj) { const f32x4 v0 = acc[ai][bj][m][0], v1 = acc[ai][bj][m][1];
                    v4u w; w.x = cvt_pk_bf16(v0[0], v0[1]); w.y = cvt_pk_bf16(v0[2], v0[3]); w.z = cvt_pk_bf16(v1[0], v1[1]); w.w = cvt_pk_bf16(v1[2], v1[3]);
                    *(v4u*)(rowp + bj * HALF) = w; } }
    }
};
struct EpiResid {
    static constexpr bool PERM = true;
    const float* x; const float* mod; bf16* X1;
    __device__ __forceinline__ void operator()(const f32x4 (&acc)[2][2][4][2], const Unit& u, int wr, int wc, int fr, int fq) const {
        const int row0 = u.pm * BM + wr * 64 + fr, col0 = u.pn * BM + wc * 32 + 8 * fq;
        const float* gt = mod + (u.pm >> 4) * MODW + 2 * D + col0;
        f32x4 gv[2][2];
#pragma unroll
        for (int bj = 0; bj < 2; ++bj)
#pragma unroll
            for (int n = 0; n < 2; ++n) gv[bj][n] = *(const f32x4*)(gt + bj * HALF + n * 4);
#pragma unroll
        for (int ai = 0; ai < 2; ++ai)
#pragma unroll
            for (int m = 0; m < 4; ++m) { const size_t off = (size_t)(row0 + ai * HALF + m * 16) * D + col0;
#pragma unroll
                for (int bj = 0; bj < 2; ++bj) { const f32x4 x0 = *(const f32x4*)(x + off + bj * HALF), x1 = *(const f32x4*)(x + off + bj * HALF + 4);
                    const f32x4 r0 = x0 + gv[bj][0] * acc[ai][bj][m][0], r1 = x1 + gv[bj][1] * acc[ai][bj][m][1];
                    v4u w; w.x = cvt2(r0[0], r0[1]); w.y = cvt2(r0[2], r0[3]); w.z = cvt2(r1[0], r1[1]); w.w = cvt2(r1[2], r1[3]);
                    *(v4u*)(X1 + off + bj * HALF) = w; }
                if (m == 3) asm volatile("" ::: "memory"); }
    }
};
struct EpiUp {
    static constexpr bool PERM = true;
    bf16* ACT; const float* b1; const int* tile_e;
    __device__ __forceinline__ void operator()(const f32x4 (&acc)[2][2][4][2], const Unit& u, int wr, int wc, int fr, int fq) const {
        const int e = tile_e[u.pm];
        const int row0 = u.pm * BM + wr * 64 + fr, f0 = u.pn * 128 + wc * 32 + 8 * fq;
        f32x4 bg[2], bl[2];
#pragma unroll
        for (int n = 0; n < 2; ++n) { bg[n] = *(const f32x4*)(b1 + (size_t)e * 4096 + f0 + 4 * n); bl[n] = *(const f32x4*)(b1 + (size_t)e * 4096 + 2048 + f0 + 4 * n); }
#pragma unroll
        for (int ai = 0; ai < 2; ++ai)
#pragma unroll
            for (int m = 0; m < 4; ++m) { bf16* rowp = ACT + (size_t)(row0 + ai * HALF + m * 16) * D + f0;
                f32x4 a[2];
#pragma unroll
                for (int n = 0; n < 2; ++n) { const f32x4 g = acc[ai][0][m][n] + bg[n], l = acc[ai][1][m][n] + bl[n];
                    a[n][0] = swiglu(g[0], l[0]); a[n][1] = swiglu(g[1], l[1]); a[n][2] = swiglu(g[2], l[2]); a[n][3] = swiglu(g[3], l[3]); }
                v4u w; w.x = cvt_pk_bf16(a[0][0], a[0][1]); w.y = cvt_pk_bf16(a[0][2], a[0][3]); w.z = cvt_pk_bf16(a[1][0], a[1][1]); w.w = cvt_pk_bf16(a[1][2], a[1][3]);
                *(v4u*)rowp = w; }
    }
};
__device__ __forceinline__ v4u widen_rows16(v2u a, v2u b) {
    const auto x = __builtin_amdgcn_permlane16_swap(a.x, b.x, false, false), y = __builtin_amdgcn_permlane16_swap(a.y, b.y, false, false);
    return (v4u){x[0], y[0], x[1], y[1]};
}
struct EpiDown {
    static constexpr bool PERM = true;
    bf16* Y; const float* b2; const int* tile_e; const float* row_gate;
    __device__ __forceinline__ void operator()(const f32x4 (&acc)[2][2][4][2], const Unit& u, int wr, int wc, int fr, int fq) const {
        const int e = tile_e[u.pm];
        const int row0 = u.pm * BM + wr * 64 + fr, col0 = u.pn * BM + wc * 32 + 8 * fq;
        f32x4 bv[2][2];
#pragma unroll
        for (int bj = 0; bj < 2; ++bj)
#pragma unroll
            for (int n = 0; n < 2; ++n) bv[bj][n] = *(const f32x4*)(b2 + (size_t)e * D + col0 + bj * HALF + 4 * n);
#pragma unroll
        for (int ai = 0; ai < 2; ++ai) {
            if (Y_FP8 && !NAIVE_GEMM) {
#pragma unroll
                for (int mp = 0; mp < 2; ++mp) { v2u w[2][2];
#pragma unroll
                    for (int mm = 0; mm < 2; ++mm) { const int m = 2 * mp + mm;
#pragma unroll
                        for (int bj = 0; bj < 2; ++bj) { const f32x4 v0 = (acc[ai][bj][m][0] + bv[bj][0]) * 8.f, v1 = (acc[ai][bj][m][1] + bv[bj][1]) * 8.f;
                            w[mm][bj].x = pk4_fp8(v0[0], v0[1], v0[2], v0[3]); w[mm][bj].y = pk4_fp8(v1[0], v1[1], v1[2], v1[3]); } }
                    unsigned char* dst = (unsigned char*)Y + (size_t)(row0 + ai * HALF + (2 * mp + (fq & 1)) * 16) * D + col0 - 8 * (fq & 1);
#pragma unroll
                    for (int bj = 0; bj < 2; ++bj) *(v4u*)(dst + bj * HALF) = widen_rows16(w[0][bj], w[1][bj]); }
            } else {
#pragma unroll
            for (int m = 0; m < 4; ++m) { const int row = row0 + ai * HALF + m * 16; const float gt = row_gate[row]; bf16* rowp = Y + (size_t)row * D + col0;
#pragma unroll
                for (int bj = 0; bj < 2; ++bj) { const f32x4 v0 = (acc[ai][bj][m][0] + bv[bj][0]) * gt, v1 = (acc[ai][bj][m][1] + bv[bj][1]) * gt;
                    v4u w; w.x = cvt_pk_bf16(v0[0], v0[1]); w.y = cvt_pk_bf16(v0[2], v0[3]); w.z = cvt_pk_bf16(v1[0], v1[1]); w.w = cvt_pk_bf16(v1[2], v1[3]);
                    *(v4u*)(rowp + bj * HALF) = w; } } } }
    }
};

struct EpiUpF8 {
    static constexpr bool PERM = true;
    unsigned char* ACT; const float* b1; const int* tile_e;
    __device__ __forceinline__ void operator()(const f32x4 (&acc)[2][2][4][2], const Unit& u, int wr, int wc, int fr, int fq) const {
        const int e = tile_e[u.pm];
        const int row0 = u.pm * BM + wr * 64 + fr, f0 = u.pn * 128 + wc * 32 + 8 * fq;
        f32x4 bg[2], bl[2];
#pragma unroll
        for (int n = 0; n < 2; ++n) { bg[n] = *(const f32x4*)(b1 + (size_t)e * 4096 + f0 + 4 * n); bl[n] = *(const f32x4*)(b1 + (size_t)e * 4096 + 2048 + f0 + 4 * n); }
#pragma unroll
        for (int ai = 0; ai < 2; ++ai)
#pragma unroll
            for (int mp = 0; mp < 2; ++mp) { v2u w[2];
#pragma unroll
                for (int mm = 0; mm < 2; ++mm) { const int m = 2 * mp + mm;
#pragma unroll
                    for (int n = 0; n < 2; ++n) { const f32x4 g = acc[ai][0][m][n] + bg[n], l = acc[ai][1][m][n] + bl[n];
                        const unsigned p = pk4_fp8_nc(swiglu(g[0], l[0]), swiglu(g[1], l[1]), swiglu(g[2], l[2]), swiglu(g[3], l[3])); if (n == 0) w[mm].x = p; else w[mm].y = p; } }
                *(v4u*)(ACT + (size_t)(row0 + ai * HALF + (2 * mp + (fq & 1)) * 16) * D + f0 - 8 * (fq & 1)) = widen_rows16(w[0], w[1]); }
    }
};
typedef int v8i __attribute__((ext_vector_type(8)));
template <class Epi>
__device__ __forceinline__ void gemm_phase_f8(LAS unsigned char* lds, const Sched& S, const Epi& E) {
    const int tid = threadIdx.x, wid = __builtin_amdgcn_readfirstlane(tid >> 6), lane = tid & 63, wr = wid >> 2, wc = wid & 3, fr = lane & 15, fq = lane >> 4;
    constexpr int KB = K;
    constexpr int nt = KB / 128;
    unsigned voffA[2], voffB[2];
#pragma unroll
    for (int i = 0; i < 2; ++i) { int R, C; stage_rc(tid * 16 + i * 8192, R, C); const int Rb = Epi::PERM ? ((R & ~31) + perm32(R & 31)) : R;
        voffA[i] = (unsigned)(R * KB + 2 * C); voffB[i] = (unsigned)(Rb * KB + 2 * C); }
    constexpr size_t kstep = 128;
    constexpr size_t hstep = (size_t)HALF * KB;
    const unsigned ldsw = (unsigned)wid * 1024u;
    const int aoff = lds_byte(wr * 64 + fr, fq * 8), boff = lds_byte(wc * 32 + fr, fq * 8), aoff2 = aoff ^ 64, boff2 = boff ^ 64;
#define PG8_SA(b, h) (((b) * 2 + (h)) * HTB)
#define PG8_SB(b, h) ((4 + (b) * 2 + (h)) * HTB)
#define PG8_STAGE(bufoff, gbase, voff) do { _Pragma("unroll") for (int _i = 0; _i < 2; ++_i) \
        __builtin_amdgcn_global_load_lds((const unsigned*)((const char*)(gbase) + (voff)[_i]), (LAS unsigned*)(lds + (bufoff) + ldsw + _i * 8192), 16, 0, 0); } while (0)
#define PG8_LD8(dst, off, offx) do { const v4u _x = *(const LAS v4u*)(lds + (off)), _y = *(const LAS v4u*)(lds + (offx)); \
        dst = (v8i){(int)_x.x, (int)_x.y, (int)_x.z, (int)_x.w, (int)_y.x, (int)_y.y, (int)_y.z, (int)_y.w}; } while (0)
#define PG8_LDA(dst, b, h) do { _Pragma("unroll") for (int m = 0; m < 4; ++m) PG8_LD8(dst[m], PG8_SA(b, h) + aoff + m * 2048, PG8_SA(b, h) + aoff2 + m * 2048); } while (0)
#define PG8_LDB(dst, b, h) do { _Pragma("unroll") for (int n = 0; n < 2; ++n) PG8_LD8(dst[n], PG8_SB(b, h) + boff + n * 2048, PG8_SB(b, h) + boff2 + n * 2048); } while (0)
#define PG8_MMA(ai, bj, At, Bt) do { __builtin_amdgcn_s_setprio(1); _Pragma("unroll") for (int m = 0; m < 4; ++m) _Pragma("unroll") for (int n = 0; n < 2; ++n) \
        asm volatile("v_mfma_scale_f32_16x16x128_f8f6f4 %0, %1, %2, %0, %3, %3 op_sel:[1,0,0] op_sel_hi:[0,0,0]" : "+v"(acc[ai][bj][m][n]) : "v"(Bt[n]), "v"(At[m]), "v"(sclv)); __builtin_amdgcn_s_setprio(0); } while (0)
#define PG8_WAIT_V(n) asm volatile("s_waitcnt vmcnt(" #n ")" ::: "memory")
#define PG8_WAIT_L(n) asm volatile("s_waitcnt lgkmcnt(" #n ")" ::: "memory")
#define PG8_BAR __builtin_amdgcn_s_barrier()
#define PG8_SCHED __builtin_amdgcn_sched_barrier(0)
    Unit cur, nxt; int ui = 0;
    if (!S.next(0, cur)) return;
    f32x4 acc[2][2][4][2];
#pragma unroll
    for (int a = 0; a < 2; ++a)
#pragma unroll
        for (int b = 0; b < 2; ++b)
#pragma unroll
            for (int m = 0; m < 4; ++m)
#pragma unroll
                for (int n = 0; n < 2; ++n) acc[a][b][m][n] = (f32x4){0.f, 0.f, 0.f, 0.f};
    v8i At[4], B0[2], B1[2];
    const int sclv = 0x0000777F;
    const char* cA = S.a_base(cur); const char* cB = S.b_base(cur);
    PG8_STAGE(PG8_SB(0, 0), cB, voffB); PG8_STAGE(PG8_SB(0, 1), cB + hstep, voffB); PG8_STAGE(PG8_SA(0, 0), cA, voffA); PG8_STAGE(PG8_SA(0, 1), cA + hstep, voffA);
    if (wr == 1) PG8_BAR;
    PG8_WAIT_V(2); PG8_BAR;
    PG8_STAGE(PG8_SB(1, 0), cB + kstep, voffB); PG8_STAGE(PG8_SA(1, 0), cA + kstep, voffA); PG8_STAGE(PG8_SB(1, 1), cB + hstep + kstep, voffB);
    PG8_WAIT_V(6); PG8_BAR;
    for (;;) {
        const bool has_next = S.next(ui + 1, nxt);
        const char* nA = has_next ? S.a_base(nxt) : cA; const char* nB = has_next ? S.b_base(nxt) : cB;
        for (int t = 0; t < nt; t += 2) {
            const bool last = (t == nt - 2);
            const char* a1 = cA + (size_t)(t + 1) * kstep;
            const char* a2 = last ? nA : cA + (size_t)(t + 2) * kstep; const char* b2 = last ? nB : cB + (size_t)(t + 2) * kstep;
            const char* a3 = a2 + kstep; const char* b3 = b2 + kstep;
            PG8_LDB(B0, 0, 0); PG8_LDB(B1, 0, 1); PG8_SCHED; PG8_LDA(At, 0, 0); PG8_STAGE(PG8_SA(1, 1), a1 + hstep, voffA);
            PG8_WAIT_V(8); PG8_WAIT_L(0); PG8_BAR; PG8_MMA(0, 0, At, B0); PG8_MMA(0, 1, At, B1); PG8_BAR; PG8_SCHED;
            PG8_LDA(At, 0, 1); PG8_STAGE(PG8_SB(0, 0), b2, voffB); PG8_STAGE(PG8_SB(0, 1), b2 + hstep, voffB); PG8_STAGE(PG8_SA(0, 0), a2, voffA);
            PG8_WAIT_V(8); PG8_WAIT_L(0); PG8_BAR; PG8_MMA(1, 0, At, B0); PG8_MMA(1, 1, At, B1); PG8_BAR; PG8_SCHED;
            PG8_LDB(B0, 1, 0); PG8_LDB(B1, 1, 1); PG8_SCHED; PG8_LDA(At, 1, 0); PG8_STAGE(PG8_SA(0, 1), a2 + hstep, voffA);
            PG8_WAIT_V(8); PG8_WAIT_L(0); PG8_BAR; PG8_MMA(0, 0, At, B0); PG8_MMA(0, 1, At, B1); PG8_BAR; PG8_SCHED;
            PG8_LDA(At, 1, 1); PG8_STAGE(PG8_SB(1, 0), b3, voffB); PG8_STAGE(PG8_SB(1, 1), b3 + hstep, voffB); PG8_STAGE(PG8_SA(1, 0), a3, voffA);
            PG8_WAIT_V(8); PG8_WAIT_L(0); PG8_BAR; PG8_MMA(1, 0, At, B0); PG8_MMA(1, 1, At, B1); PG8_BAR; PG8_SCHED;
        }
        if (wr == 0) PG8_BAR;
        asm volatile("s_nop 15\n\ts_nop 15" ::: "memory");
        E(acc, cur, wr, wc, fr, fq);
        if (!has_next) break;
#pragma unroll
        for (int a = 0; a < 2; ++a)
#pragma unroll
            for (int b = 0; b < 2; ++b)
#pragma unroll
                for (int m = 0; m < 4; ++m)
#pragma unroll
                    for (int n = 0; n < 2; ++n) acc[a][b][m][n] = (f32x4){0.f, 0.f, 0.f, 0.f};
        asm volatile("s_nop 7" ::: "memory");
        cur = nxt; cA = nA; cB = nB; ++ui;
        if (wr == 1) PG8_BAR;
    }
    PG8_WAIT_V(0);
    PG8_BAR;
#undef PG8_SA
#undef PG8_SB
#undef PG8_STAGE
#undef PG8_LD8
#undef PG8_LDA
#undef PG8_LDB
#undef PG8_MMA
#undef PG8_WAIT_V
#undef PG8_WAIT_L
#undef PG8_BAR
#undef PG8_SCHED
}

template <class Epi>
__device__ __forceinline__ void gemm_phase(LAS unsigned char* lds, const Sched& S, const Epi& E) {
    const int tid = threadIdx.x, wid = __builtin_amdgcn_readfirstlane(tid >> 6), lane = tid & 63, wr = wid >> 2, wc = wid & 3, fr = lane & 15, fq = lane >> 4;
    constexpr int nt = K / BK;
    unsigned voffA[2], voffB[2];
#pragma unroll
    for (int i = 0; i < 2; ++i) { int R, C; stage_rc(tid * 16 + i * 8192, R, C); const int Rb = Epi::PERM ? ((R & ~31) + perm32(R & 31)) : R;
        voffA[i] = (unsigned)(R * K + C) * 2u; voffB[i] = (unsigned)(Rb * K + C) * 2u; }
    constexpr size_t kstep = (size_t)(BK * 2);
    constexpr size_t hstep = (size_t)HALF * K * 2;
    const unsigned ldsw = (unsigned)wid * 1024u;
    const int aoff = lds_byte(wr * 64 + fr, fq * 8), boff = lds_byte(wc * 32 + fr, fq * 8), aoff2 = aoff ^ 64, boff2 = boff ^ 64;
#define PG8_SA(b, h) (((b) * 2 + (h)) * HTB)
#define PG8_SB(b, h) ((4 + (b) * 2 + (h)) * HTB)
#define PG8_STAGE(bufoff, gbase, voff) do { _Pragma("unroll") for (int _i = 0; _i < 2; ++_i) \
        __builtin_amdgcn_global_load_lds((const unsigned*)((const char*)(gbase) + (voff)[_i]), (LAS unsigned*)(lds + (bufoff) + ldsw + _i * 8192), 16, 0, 0); } while (0)
#define PG8_LDA(dst, b, h) do { _Pragma("unroll") for (int m = 0; m < 4; ++m) _Pragma("unroll") for (int k = 0; k < 2; ++k) dst[m][k] = *(const LAS bf16x8*)(lds + PG8_SA(b, h) + (k ? aoff2 : aoff) + m * 2048); } while (0)
#define PG8_LDB(dst, b, h) do { _Pragma("unroll") for (int n = 0; n < 2; ++n) _Pragma("unroll") for (int k = 0; k < 2; ++k) dst[n][k] = *(const LAS bf16x8*)(lds + PG8_SB(b, h) + (k ? boff2 : boff) + n * 2048); } while (0)
#define PG8_MMA(ai, bj, At, Bt) do { __builtin_amdgcn_s_setprio(1); _Pragma("unroll") for (int m = 0; m < 4; ++m) _Pragma("unroll") for (int n = 0; n < 2; ++n) _Pragma("unroll") for (int k = 0; k < 2; ++k) \
        acc[ai][bj][m][n] = __builtin_amdgcn_mfma_f32_16x16x32_bf16(Bt[n][k], At[m][k], acc[ai][bj][m][n], 0, 0, 0); __builtin_amdgcn_s_setprio(0); } while (0)
#define PG8_WAIT_V(n) asm volatile("s_waitcnt vmcnt(" #n ")" ::: "memory")
#define PG8_WAIT_L(n) asm volatile("s_waitcnt lgkmcnt(" #n ")" ::: "memory")
#define PG8_BAR __builtin_amdgcn_s_barrier()
#define PG8_SCHED __builtin_amdgcn_sched_barrier(0)
    Unit cur, nxt; int ui = 0;
    if (!S.next(0, cur)) return;
    f32x4 acc[2][2][4][2];
#pragma unroll
    for (int a = 0; a < 2; ++a)
#pragma unroll
        for (int b = 0; b < 2; ++b)
#pragma unroll
            for (int m = 0; m < 4; ++m)
#pragma unroll
                for (int n = 0; n < 2; ++n) acc[a][b][m][n] = (f32x4){0.f, 0.f, 0.f, 0.f};
    bf16x8 At[4][2], B0[2][2], B1[2][2];
    const char* cA = S.a_base(cur); const char* cB = S.b_base(cur);
    PG8_STAGE(PG8_SB(0, 0), cB, voffB); PG8_STAGE(PG8_SB(0, 1), cB + hstep, voffB); PG8_STAGE(PG8_SA(0, 0), cA, voffA); PG8_STAGE(PG8_SA(0, 1), cA + hstep, voffA);
    if (wr == 1) PG8_BAR;
    PG8_WAIT_V(2); PG8_BAR;
    PG8_STAGE(PG8_SB(1, 0), cB + kstep, voffB); PG8_STAGE(PG8_SA(1, 0), cA + kstep, voffA); PG8_STAGE(PG8_SB(1, 1), cB + hstep + kstep, voffB);
    PG8_WAIT_V(6); PG8_BAR;
    for (;;) {
        const bool has_next = S.next(ui + 1, nxt);
        const char* nA = has_next ? S.a_base(nxt) : cA; const char* nB = has_next ? S.b_base(nxt) : cB;
        for (int t = 0; t < nt; t += 2) {
            const bool last = (t == nt - 2);
            const char* a1 = cA + (size_t)(t + 1) * kstep;
            const char* a2 = last ? nA : cA + (size_t)(t + 2) * kstep; const char* b2 = last ? nB : cB + (size_t)(t + 2) * kstep;
            const char* a3 = a2 + kstep; const char* b3 = b2 + kstep;
            PG8_LDB(B0, 0, 0); PG8_LDB(B1, 0, 1); PG8_SCHED; PG8_LDA(At, 0, 0); PG8_STAGE(PG8_SA(1, 1), a1 + hstep, voffA);
            PG8_WAIT_V(8); PG8_WAIT_L(0); PG8_BAR; PG8_MMA(0, 0, At, B0); PG8_MMA(0, 1, At, B1); PG8_BAR; PG8_SCHED;
            PG8_LDA(At, 0, 1); PG8_STAGE(PG8_SB(0, 0), b2, voffB); PG8_STAGE(PG8_SB(0, 1), b2 + hstep, voffB); PG8_STAGE(PG8_SA(0, 0), a2, voffA);
            PG8_WAIT_V(8); PG8_WAIT_L(0); PG8_BAR; PG8_MMA(1, 0, At, B0); PG8_MMA(1, 1, At, B1); PG8_BAR; PG8_SCHED;
            PG8_LDB(B0, 1, 0); PG8_LDB(B1, 1, 1); PG8_SCHED; PG8_LDA(At, 1, 0); PG8_STAGE(PG8_SA(0, 1), a2 + hstep, voffA);
            PG8_WAIT_V(8); PG8_WAIT_L(0); PG8_BAR; PG8_MMA(0, 0, At, B0); PG8_MMA(0, 1, At, B1); PG8_BAR; PG8_SCHED;
            PG8_LDA(At, 1, 1); PG8_STAGE(PG8_SB(1, 0), b3, voffB); PG8_STAGE(PG8_SB(1, 1), b3 + hstep, voffB); PG8_STAGE(PG8_SA(1, 0), a3, voffA);
            PG8_WAIT_V(8); PG8_WAIT_L(0); PG8_BAR; PG8_MMA(1, 0, At, B0); PG8_MMA(1, 1, At, B1); PG8_BAR; PG8_SCHED;
        }
        if (wr == 0) PG8_BAR;
        E(acc, cur, wr, wc, fr, fq);
        if (!has_next) break;
#pragma unroll
        for (int a = 0; a < 2; ++a)
#pragma unroll
            for (int b = 0; b < 2; ++b)
#pragma unroll
                for (int m = 0; m < 4; ++m)
#pragma unroll
                    for (int n = 0; n < 2; ++n) acc[a][b][m][n] = (f32x4){0.f, 0.f, 0.f, 0.f};
        cur = nxt; cA = nA; cB = nB; ++ui;
        if (wr == 1) PG8_BAR;
    }
    PG8_WAIT_V(0);
    PG8_BAR;
#undef PG8_SA
#undef PG8_SB
#undef PG8_STAGE
#undef PG8_LDA
#undef PG8_LDB
#undef PG8_MMA
#undef PG8_WAIT_V
#undef PG8_WAIT_L
#undef PG8_BAR
#undef PG8_SCHED
}
}

#define MFMA16(a, b, cc) __builtin_amdgcn_mfma_f32_16x16x32_bf16(a, b, cc, 0, 0, 0)
__device__ __forceinline__ bf16x8 pack8(const f32x4 lo, const f32x4 hi) {
    v4u w; w.x = cvt2(lo[0], lo[1]); w.y = cvt2(lo[2], lo[3]); w.z = cvt2(hi[0], hi[1]); w.w = cvt2(hi[2], hi[3]);
    return __builtin_bit_cast(bf16x8, w);
}
__device__ __forceinline__ bf16x8 ld2x8(const LAS bf16* p0, const LAS bf16* p1) {
    const v2u a = *(const LAS v2u*)p0, b = *(const LAS v2u*)p1; v4u w; w.x = a.x; w.y = a.y; w.z = b.x; w.w = b.y; return __builtin_bit_cast(bf16x8, w);
}
#define TP(r) ((((r) & 7) * 17) + ((r) >> 3))
struct GdnLds { LAS float *sb, *sg; LAS bf16 *Qn, *Kn, *Vt, *Kt; LAS float* Lm; LAS bf16* Tm; };
__device__ __forceinline__ void gdn_conv_compute(const Ctx& c, int ug, v4u (&rows)[8], v4u (&cols)[8], float& beta_o, float& g_o) {
    const int n = ug & 63, h = (ug >> 6) & 7, b = ug >> 9, t0 = n * 64; const size_t rowbase = (size_t)b * SEQ;
    const int lane = c.lane, w = c.wave;
    const int cg = c.tid & 15, oct = (c.tid >> 4) & 7, mat = w >> 1;
    const int col = mat * 1024 + h * 128 + 8 * cg;
    v4u rr[11];
#pragma unroll
    for (int i = 0; i < 11; ++i) { const int tt = t0 + 8 * oct - 3 + i; const v4u ld = *(const v4u*)(c.PROJ + (rowbase + (tt < 0 ? 0 : tt)) * NPROJ + col); const unsigned msk = tt < 0 ? 0u : 0xffffffffu; rr[i] = (v4u){ld.x & msk, ld.y & msk, ld.z & msk, ld.w & msk}; }
    f32x4 cw[4][2];
#pragma unroll
    for (int i = 0; i < 4; ++i) { cw[i][0] = *(const f32x4*)(c.conv_w + i * 3072 + col); cw[i][1] = *(const f32x4*)(c.conv_w + i * 3072 + col + 4); }
    if (w == 0) {
        const size_t row = rowbase + t0 + lane;
        beta_o = sigmoidf_(c.ba[row * 16 + h]);
        float gs = -expf(c.a_log[h]) * softplusf_(c.ba[row * 16 + 8 + h] + c.dt_bias[h]);
#pragma unroll
        for (int o = 1; o < 64; o <<= 1) { const float t = __shfl_up(gs, o); if (lane >= o) gs += t; }
        g_o = gs;
    }
#pragma unroll
    for (int tp = 0; tp < 4; ++tp) {
        float y[2][8];
#pragma unroll
        for (int hh = 0; hh < 2; ++hh) { const int tk = 2 * tp + hh;
#pragma unroll
            for (int e = 0; e < 8; ++e) y[hh][e] = 0.f;
#pragma unroll
            for (int i = 0; i < 4; ++i) { const v4u ru = rr[tk + i]; const f32x4 u0 = {bflo(ru.x), bfhi(ru.x), bflo(ru.y), bfhi(ru.y)}, u1 = {bflo(ru.z), bfhi(ru.z), bflo(ru.w), bfhi(ru.w)};
                y[hh][0] += cw[i][0].x * u0.x; y[hh][1] += cw[i][0].y * u0.y; y[hh][2] += cw[i][0].z * u0.z; y[hh][3] += cw[i][0].w * u0.w;
                y[hh][4] += cw[i][1].x * u1.x; y[hh][5] += cw[i][1].y * u1.y; y[hh][6] += cw[i][1].z * u1.z; y[hh][7] += cw[i][1].w * u1.w; }
#pragma unroll
            for (int e = 0; e < 8; ++e) y[hh][e] = siluf(y[hh][e]);
            if (mat < 2) {
                float ss = 0.f;
#pragma unroll
                for (int e = 0; e < 8; ++e) ss += y[hh][e] * y[hh][e];
                ss += __shfl_xor(ss, 1); ss += __shfl_xor(ss, 2); ss += __shfl_xor(ss, 4); ss += __shfl_xor(ss, 8);
                const float rs = rsqrtf(ss + EPS) * (mat == 0 ? 0.08838834764831845f : 1.f);
#pragma unroll
                for (int e = 0; e < 8; ++e) y[hh][e] *= rs;
                v4u pw; pw.x = pk2(y[hh][0], y[hh][1]); pw.y = pk2(y[hh][2], y[hh][3]); pw.z = pk2(y[hh][4], y[hh][5]); pw.w = pk2(y[hh][6], y[hh][7]);
                rows[tk] = pw;
            }
        }
        if (mat >= 1) {
#pragma unroll
            for (int e = 0; e < 8; ++e) { const unsigned wd = pk2(y[0][e], y[1][e]); if (tp == 0) cols[e].x = wd; else if (tp == 1) cols[e].y = wd; else if (tp == 2) cols[e].z = wd; else cols[e].w = wd; } }
    }
}
__device__ __forceinline__ void gdn_conv_write(const Ctx& c, int ug, const GdnLds& P, const v4u (&rows)[8], const v4u (&cols)[8], float beta, float g) {
    const int w = c.wave, cg = c.tid & 15, oct = (c.tid >> 4) & 7, mat = w >> 1;
    if (mat < 2) {
#pragma unroll
        for (int tk = 0; tk < 8; ++tk) *(LAS v4u*)((mat == 0 ? P.Qn : P.Kn) + (8 * oct + tk) * 136 + 8 * cg) = rows[tk]; }
    if (mat >= 1) { LAS bf16* dt = (mat == 1 ? P.Kt : P.Vt);
#pragma unroll
        for (int e = 0; e < 8; ++e) *(LAS v4u*)(dt + TP(8 * cg + e) * 72 + 8 * oct) = cols[e]; }
    if (w == 0) { P.sb[c.lane] = beta; P.sg[c.lane] = g; if (c.lane == 63) c.gcd[ug] = expf(g); }
}
__device__ __forceinline__ void gdn_step2(const Ctx& c, int ug, const GdnLds& P) {
    const int lane = c.lane, q = lane >> 4, r = lane & 15, w = c.wave;
    unsigned char* img = c.gimg + (size_t)ug * GIMG_BYTES;
    LAS bf16* Qn = P.Qn; LAS bf16* Kn = P.Kn; LAS float* sb = P.sb; LAS float* sg = P.sg; LAS float* Lm = P.Lm;
#pragma unroll
    for (int tt = 0; tt < 2; ++tt) { const int tile = 2 * w + tt, ib = tile >> 2, jb = tile & 3;
        f32x4 acc = {0.f, 0.f, 0.f, 0.f};
#pragma unroll
        for (int s = 0; s < 4; ++s) { const bf16x8 a = *(const LAS bf16x8*)(Kn + (16 * ib + r) * 136 + 32 * s + 8 * q), bb = *(const LAS bf16x8*)(Kn + (16 * jb + r) * 136 + 32 * s + 8 * q); acc = MFMA16(a, bb, acc); }
        const int j = 16 * jb + r; const float gj = sg[j];
#pragma unroll
        for (int d = 0; d < 4; ++d) { const int i = 16 * ib + 4 * q + d; Lm[i * 68 + j] = (j < i) ? sb[i] * acc[d] * __expf(sg[i] - gj) : 0.f; } }
    { const int ib = w >> 1, s2 = w & 1;
        f32x4 a0 = {0.f, 0.f, 0.f, 0.f}, a1 = {0.f, 0.f, 0.f, 0.f};
#pragma unroll
        for (int s = 0; s < 4; ++s) { const bf16x8 bq = *(const LAS bf16x8*)(Qn + (16 * ib + r) * 136 + 32 * s + 8 * q);
            const bf16x8 k0 = *(const LAS bf16x8*)(Kn + (32 * s2 + r) * 136 + 32 * s + 8 * q), k1 = *(const LAS bf16x8*)(Kn + (32 * s2 + 16 + r) * 136 + 32 * s + 8 * q);
            a0 = MFMA16(k0, bq, a0); a1 = MFMA16(k1, bq, a1); }
        const int i = 16 * ib + r; const float gi = sg[i]; f32x4 o0, o1;
#pragma unroll
        for (int d = 0; d < 4; ++d) { const int j0 = 32 * s2 + 4 * q + d, j1 = j0 + 16;
            o0[d] = (j0 <= i) ? a0[d] * __expf(gi - sg[j0]) : 0.f; o1[d] = (j1 <= i) ? a1[d] * __expf(gi - sg[j1]) : 0.f; }
        *(bf16x8*)(img + 32768 + ((ib * 2 + s2) * 64 + lane) * 16) = pack8(o0, o1); }
}
__device__ __forceinline__ void gdn_solve(const Ctx& c, const GdnLds& P, int copy) {
    const int lane = c.lane;
    float Tc[64];
    int zoff = 0; asm volatile("v_mov_b32 %0, 0" : "=v"(zoff));
    const LAS float* Lz = P.Lm + zoff;
    const float scl = P.sb[lane] * (copy == 0 ? 1.f : expf(P.sg[lane]));
#define LROW(dst, row, half, nv) do { _Pragma("unroll") for (int _k = 0; _k < (nv); ++_k) dst[_k] = *(const LAS f32x4*)(Lz + (row) * 68 + 32 * (half) + 4 * _k); } while (0)
    f32x4 X[8], Y[8];
    Tc[0] = (lane == 0) ? scl : 0.f;
    LROW(Y, 1, 0, 1);
#pragma unroll
    for (int i = 1; i < 32; ++i) {
        if (i & 1) LROW(X, i + 1, 0, (i + 4) / 4 > 8 ? 8 : (i + 4) / 4); else LROW(Y, i + 1, 0, (i + 4) / 4 > 8 ? 8 : (i + 4) / 4);
        __builtin_amdgcn_sched_barrier(0);
        float a0 = (i == lane) ? scl : 0.f, a1 = 0.f, a2 = 0.f, a3 = 0.f;
#pragma unroll
        for (int m = 0; m < i; ++m) { const float lv = ((i & 1) ? Y[m >> 2][m & 3] : X[m >> 2][m & 3]);
            if ((m & 3) == 0) a0 -= lv * Tc[m]; else if ((m & 3) == 1) a1 -= lv * Tc[m]; else if ((m & 3) == 2) a2 -= lv * Tc[m]; else a3 -= lv * Tc[m]; }
        Tc[i] = (a0 + a1) + (a2 + a3);
        __builtin_amdgcn_sched_barrier(0);
    }
#pragma unroll
    for (int i = 32; i < 64; ++i) {
        if (i > 32) LROW(Y, i, 1, (i - 32 + 3) / 4);
        __builtin_amdgcn_sched_barrier(0);
        float a0 = (i == lane) ? scl : 0.f, a1 = 0.f, a2 = 0.f, a3 = 0.f;
#pragma unroll
        for (int m = 0; m < 32; ++m) { const float lv = X[m >> 2][m & 3];
            if ((m & 3) == 0) a0 -= lv * Tc[m]; else if ((m & 3) == 1) a1 -= lv * Tc[m]; else if ((m & 3) == 2) a2 -= lv * Tc[m]; else a3 -= lv * Tc[m]; }
        __builtin_amdgcn_sched_barrier(0);
        if (i + 1 < 64) LROW(X, i + 1, 0, 8);
        __builtin_amdgcn_sched_barrier(0);
#pragma unroll
        for (int m = 32; m < i; ++m) { const float lv = Y[(m - 32) >> 2][m & 3];
            if ((m & 3) == 0) a0 -= lv * Tc[m]; else if ((m & 3) == 1) a1 -= lv * Tc[m]; else if ((m & 3) == 2) a2 -= lv * Tc[m]; else a3 -= lv * Tc[m]; }
        Tc[i] = (a0 + a1) + (a2 + a3);
        __builtin_amdgcn_sched_barrier(0);
    }
#undef LROW
    LAS bf16* Td = P.Tm + copy * 4608;
#pragma unroll
    for (int i = 0; i < 64; ++i) Td[i * 72 + lane] = (bf16)f2bf(Tc[i]);
}
constexpr int PT_OFF = 110592, QR_OFF = 113152, PQ_STRIDE = 40;
__device__ __forceinline__ void gdn_solve_half(const Ctx& c, const GdnLds& P, int blk) {
    const int lane = c.lane, j = lane & 31;
    float Tc[32];
    int zoff = 0; asm volatile("v_mov_b32 %0, 0" : "=v"(zoff));
    const LAS float* Lz = P.Lm + zoff + blk * (32 * 68 + 32);
#define LROW(dst, row, nv) do { _Pragma("unroll") for (int _k = 0; _k < (nv); ++_k) dst[_k] = *(const LAS f32x4*)(Lz + (row) * 68 + 4 * _k); } while (0)
    float one; asm volatile("v_mov_b32 %0, 1.0" : "=v"(one));
    f32x4 X[8], Y[8];
    Tc[0] = (j == 0) ? one : 0.f;
    LROW(Y, 1, 1);
#pragma unroll
    for (int i = 1; i < 32; ++i) {
        if (i + 1 < 32) { if (i & 1) LROW(X, i + 1, (i + 4) / 4); else LROW(Y, i + 1, (i + 4) / 4); }
        __builtin_amdgcn_sched_barrier(0);
        float a0 = (i == j) ? one : 0.f, a1 = 0.f, a2 = 0.f, a3 = 0.f;
#pragma unroll
        for (int m = 0; m < i; ++m) { const float lv = ((i & 1) ? Y[m >> 2][m & 3] : X[m >> 2][m & 3]);
            if ((m & 3) == 0) a0 -= lv * Tc[m]; else if ((m & 3) == 1) a1 -= lv * Tc[m]; else if ((m & 3) == 2) a2 -= lv * Tc[m]; else a3 -= lv * Tc[m]; }
        { float tci = (a0 + a1) + (a2 + a3); asm volatile("" : "+v"(tci) :: "memory"); Tc[i] = tci; }
        __builtin_amdgcn_sched_barrier(0);
    }
#undef LROW
    if (lane < 32) {
        const int col = 32 * blk + j;
        const float s0 = P.sb[col], s1 = s0 * expf(P.sg[col]);
        LAS bf16* T0 = P.Tm + (32 * blk) * 72 + col; LAS bf16* T1 = T0 + 4608;
#pragma unroll
        for (int i = 0; i < 32; ++i) { T0[i * 72] = (bf16)f2bf(Tc[i] * s0); T1[i * 72] = (bf16)f2bf(Tc[i] * s1); }
        if (blk == 0) {
            LAS bf16* Pt = (LAS bf16*)(c.lds + PT_OFF) + j * PQ_STRIDE;
#pragma unroll
            for (int k4 = 0; k4 < 4; ++k4) { v4u w; w.x = cvt2(Tc[8 * k4], Tc[8 * k4 + 1]); w.y = cvt2(Tc[8 * k4 + 2], Tc[8 * k4 + 3]); w.z = cvt2(Tc[8 * k4 + 4], Tc[8 * k4 + 5]); w.w = cvt2(Tc[8 * k4 + 6], Tc[8 * k4 + 7]);
                *(LAS v4u*)(Pt + 8 * k4) = w; }
        } else {
            LAS bf16* Qr = (LAS bf16*)(c.lds + QR_OFF) + j;
#pragma unroll
            for (int i = 0; i < 32; ++i) Qr[i * PQ_STRIDE] = (bf16)f2bf(Tc[i]);
            LAS bf16* Z0 = P.Tm + col; LAS bf16* Z1 = Z0 + 4608;
#pragma unroll
            for (int i = 0; i < 32; ++i) { Z0[i * 72] = (bf16)0; Z1[i * 72] = (bf16)0; }
        }
    }
}
__device__ __forceinline__ void gdn_solve_offdiag(const Ctx& c, const GdnLds& P, int jb) {
    const int lane = c.lane, q = lane >> 4, r = lane & 15;
    const LAS bf16* Pt = (const LAS bf16*)(c.lds + PT_OFF); const LAS bf16* Qr = (const LAS bf16*)(c.lds + QR_OFF);
    const bf16x8 pb = *(const LAS bf16x8*)(Pt + (16 * jb + r) * PQ_STRIDE + 8 * q);
    f32x4 m[2];
#pragma unroll
    for (int kb = 0; kb < 2; ++kb) { const LAS float* lr = P.Lm + (32 + 16 * kb + r) * 68 + 8 * q;
        const f32x4 l0 = *(const LAS f32x4*)lr, l1 = *(const LAS f32x4*)(lr + 4);
        m[kb] = MFMA16(pack8(l0, l1), pb, ((f32x4){0.f, 0.f, 0.f, 0.f})); }
    const bf16x8 mb = pack8(m[0], m[1]);
    const int col = 16 * jb + r;
    const float s0 = P.sb[col], s1 = s0 * expf(P.sg[col]);
#pragma unroll
    for (int ib = 0; ib < 2; ++ib) { const LAS bf16* qrow = Qr + (16 * ib + r) * PQ_STRIDE;
        const f32x4 rr = MFMA16(ld2x8(qrow + 4 * q, qrow + 16 + 4 * q), mb, ((f32x4){0.f, 0.f, 0.f, 0.f}));
        LAS bf16* T0 = P.Tm + (32 + 16 * ib + 4 * q) * 72 + col; LAS bf16* T1 = T0 + 4608;
#pragma unroll
        for (int d = 0; d < 4; ++d) { T0[d * 72] = (bf16)f2bf(-rr[d] * s0); T1[d * 72] = (bf16)f2bf(-rr[d] * s1); } }
}
__device__ __forceinline__ void gdn_exports(const Ctx& c, int ug, const GdnLds& P, int f0, int f1, int fstep) {
    const int lane = c.lane, q = lane >> 4, r = lane & 15;
    unsigned char* img = c.gimg + (size_t)ug * GIMG_BYTES;
    LAS bf16* Qn = P.Qn; LAS bf16* Kn = P.Kn; LAS float* sg = P.sg;
    const float glast = sg[63];
    for (int f = f0; f < f1; f += fstep) {
        if (f < 16) { const int mb = f >> 2, s = f & 3, i = 16 * mb + r; const LAS bf16* p = Qn + i * 136 + 32 * s + 4 * q;
            const v2u lo = *(const LAS v2u*)p, hi = *(const LAS v2u*)(p + 16); const float eg = __expf(sg[i]);
            const f32x4 a = {bflo(lo.x) * eg, bfhi(lo.x) * eg, bflo(lo.y) * eg, bfhi(lo.y) * eg}, bb = {bflo(hi.x) * eg, bfhi(hi.x) * eg, bflo(hi.y) * eg, bfhi(hi.y) * eg};
            *(bf16x8*)(img + 16384 + ((mb * 4 + s) * 64 + lane) * 16) = pack8(a, bb);
        } else { const int ff = f - 16, db = ff >> 1, s2 = ff & 1, dk = 16 * db + r; f32x4 a, bb;
#pragma unroll
            for (int e = 0; e < 4; ++e) { const int j0 = 32 * s2 + 4 * q + e, j1 = j0 + 16;
                a[e] = bf2f(Kn[j0 * 136 + dk]) * __expf(glast - sg[j0]); bb[e] = bf2f(Kn[j1 * 136 + dk]) * __expf(glast - sg[j1]); }
            *(bf16x8*)(img + 40960 + ((db * 2 + s2) * 64 + lane) * 16) = pack8(a, bb); }
    }
}
__device__ __forceinline__ void gdn_step4(const Ctx& c, int ug, const GdnLds& P) {
    const int lane = c.lane, q = lane >> 4, r = lane & 15, w = c.wave;
    unsigned char* img = c.gimg + (size_t)ug * GIMG_BYTES; float* uimg = c.gu + (size_t)ug * 8192;
    LAS bf16* Tm = P.Tm; LAS bf16* Vt = P.Vt; LAS bf16* Kt = P.Kt;
#pragma unroll
    for (int mb = 0; mb < 4; ++mb) { f32x4 acc = {0.f, 0.f, 0.f, 0.f};
#pragma unroll
        for (int s2 = 0; s2 < 2; ++s2) { const bf16x8 a = *(const LAS bf16x8*)(Tm + (16 * mb + r) * 72 + 32 * s2 + 8 * q), bb = *(const LAS bf16x8*)(Vt + TP(16 * w + r) * 72 + 32 * s2 + 8 * q); acc = MFMA16(a, bb, acc); }
        { v2u pw; pw.x = cvt2(acc[0], acc[1]); pw.y = cvt2(acc[2], acc[3]); *(v2u*)((bf16*)uimg + ((w * 4 + mb) * 64 + lane) * 4) = pw; } }
#pragma unroll
    for (int ff = 0; ff < 2; ++ff) { const int f = 2 * w + ff, mb = f >> 2, s = f & 3;
        f32x4 a0 = {0.f, 0.f, 0.f, 0.f}, a1 = {0.f, 0.f, 0.f, 0.f};
#pragma unroll
        for (int s2 = 0; s2 < 2; ++s2) { const bf16x8 bt = *(const LAS bf16x8*)(Tm + 4608 + (16 * mb + r) * 72 + 32 * s2 + 8 * q);
            const bf16x8 k0 = *(const LAS bf16x8*)(Kt + TP(32 * s + r) * 72 + 32 * s2 + 8 * q), k1 = *(const LAS bf16x8*)(Kt + TP(32 * s + 16 + r) * 72 + 32 * s2 + 8 * q);
            a0 = MFMA16(k0, bt, a0); a1 = MFMA16(k1, bt, a1); }
        *(bf16x8*)(img + ((mb * 4 + s) * 64 + lane) * 16) = pack8(-a0, -a1); }
}
__device__ __forceinline__ void prep_gdn_all(const Ctx& c) {
    GdnLds P;
    P.sb = (LAS float*)c.lds; P.sg = P.sb + 64;
    P.Qn = (LAS bf16*)(c.lds + 1024);
    P.Kn = (LAS bf16*)(c.lds + 18432);
    P.Vt = (LAS bf16*)(c.lds + 35840);
    P.Kt = (LAS bf16*)(c.lds + 55296);
    P.Lm = (LAS float*)(c.lds + 74752);
    P.Tm = (LAS bf16*)(c.lds + 92160);
    const int w = c.wave;
    v4u rows[8], cols[8]; float beta = 0.f, g = 0.f;
#pragma unroll
    for (int i = 0; i < 8; ++i) { rows[i] = (v4u){0u, 0u, 0u, 0u}; cols[i] = (v4u){0u, 0u, 0u, 0u}; }
    int ug = c.bid;
    if (ug < 2048 && w < 6) gdn_conv_compute(c, ug, rows, cols, beta, g);
    for (; ug < 2048; ug += c.G) {
        if (w < 6) gdn_conv_write(c, ug, P, rows, cols, beta, g);
        __syncthreads();
        gdn_step2(c, ug, P);
        __syncthreads();
        if (w >= 6) { gdn_solve_half(c, P, w - 6); gdn_exports(c, ug, P, 18 + (w - 6), 32, 2);
#pragma unroll
            for (int i = 0; i < 8; ++i) { rows[i] = (v4u){0u, 0u, 0u, 0u}; cols[i] = (v4u){0u, 0u, 0u, 0u}; } }
        else { gdn_exports(c, ug, P, w, 18, 6); if (ug + c.G < 2048) gdn_conv_compute(c, ug + c.G, rows, cols, beta, g); }
        __syncthreads();
        if (w < 2) gdn_solve_offdiag(c, P, w);
        __syncthreads();
        gdn_step4(c, ug, P);
        __syncthreads();
    }
}
#undef TP
__device__ __forceinline__ void prep_ret(const Ctx& c, int ur) {
    const int n = ur & 63, h = (ur >> 6) & 3, b = ur >> 8, t0 = n * 64;
    const size_t rowbase = (size_t)b * SEQ + t0;
    const int lane = c.lane, q = lane >> 4, r = lane & 15, w = c.wave;
    LAS bf16* Qr = (LAS bf16*)c.lds;
    LAS bf16* Kr = (LAS bf16*)(c.lds + 33792);
    LAS bf16* Vt = (LAS bf16*)(c.lds + 67584);
    unsigned char* img = c.rimg + (size_t)ur * RIMG_BYTES; float* inner = c.rinner + (size_t)ur * 16384; unsigned char* vf = c.rvf + (size_t)ur * 32768;
    const float lg2 = log2f(1.f - exp2f(-5.f - (float)h));
    {
        v4u qa[2], qb[2], ka[2], kb[2]; f32x4 cs[2][4];
#pragma unroll
        for (int it = 0; it < 2; ++it) { const int item = it * NTHREADS + c.tid, tok = item >> 4, i0 = (item & 15) * 8; const size_t row = rowbase + tok;
            const bf16* pr = c.PROJ + row * NPROJ + 4096 + h * 256 + i0;
            qa[it] = *(const v4u*)pr; qb[it] = *(const v4u*)(pr + 128); ka[it] = *(const v4u*)(pr + 1024); kb[it] = *(const v4u*)(pr + 1024 + 128);
            const f32x4* rp = (const f32x4*)(c.rot + row * 128 + i0);
#pragma unroll
            for (int p = 0; p < 4; ++p) cs[it][p] = rp[p]; }
#pragma unroll
        for (int it = 0; it < 2; ++it) { const int item = it * NTHREADS + c.tid, tok = item >> 4, i0 = (item & 15) * 8;
            const unsigned qaw[4] = {qa[it].x, qa[it].y, qa[it].z, qa[it].w}, qbw[4] = {qb[it].x, qb[it].y, qb[it].z, qb[it].w}, kaw[4] = {ka[it].x, ka[it].y, ka[it].z, ka[it].w}, kbw[4] = {kb[it].x, kb[it].y, kb[it].z, kb[it].w};
            unsigned oq1[4], oq2[4], ok1[4], ok2[4];
#pragma unroll
            for (int p = 0; p < 4; ++p) { float r1[2], r2[2], r3[2], r4[2];
#pragma unroll
                for (int hh = 0; hh < 2; ++hh) { const float cc = hh ? cs[it][p].z : cs[it][p].x, sn = hh ? cs[it][p].w : cs[it][p].y;
                    const float x1 = hh ? bfhi(qaw[p]) : bflo(qaw[p]), x2 = hh ? bfhi(qbw[p]) : bflo(qbw[p]), y1 = hh ? bfhi(kaw[p]) : bflo(kaw[p]), y2 = hh ? bfhi(kbw[p]) : bflo(kbw[p]);
                    r1[hh] = x1 * cc - x2 * sn; r2[hh] = x2 * cc + x1 * sn; r3[hh] = (y1 * cc - y2 * sn) * 0.0625f; r4[hh] = (y2 * cc + y1 * sn) * 0.0625f; }
                oq1[p] = pk2(r1[0], r1[1]); oq2[p] = pk2(r2[0], r2[1]); ok1[p] = pk2(r3[0], r3[1]); ok2[p] = pk2(r4[0], r4[1]); }
            v4u t;
            t.x = oq1[0]; t.y = oq1[1]; t.z = oq1[2]; t.w = oq1[3]; *(LAS v4u*)(Qr + tok * 264 + i0) = t;
            t.x = oq2[0]; t.y = oq2[1]; t.z = oq2[2]; t.w = oq2[3]; *(LAS v4u*)(Qr + tok * 264 + 128 + i0) = t;
            t.x = ok1[0]; t.y = ok1[1]; t.z = ok1[2]; t.w = ok1[3]; *(LAS v4u*)(Kr + tok * 264 + i0) = t;
            t.x = ok2[0]; t.y = ok2[1]; t.z = ok2[2]; t.w = ok2[3]; *(LAS v4u*)(Kr + tok * 264 + 128 + i0) = t; }
    }
    { v4u vv[4];
#pragma unroll
        for (int it = 0; it < 4; ++it) { const int item = it * NTHREADS + c.tid, tok = item & 63, vg = item >> 6; vv[it] = *(const v4u*)(c.PROJ + (rowbase + tok) * NPROJ + 6144 + h * 256 + 8 * vg); }
#pragma unroll
        for (int it = 0; it < 4; ++it) { const int item = it * NTHREADS + c.tid, tok = item & 63, vg = item >> 6; const v4u u = vv[it];
            LAS bf16* d = Vt + (8 * vg) * 72 + tok;
            d[0] = (bf16)(u.x & 0xffff); d[72] = (bf16)(u.x >> 16); d[144] = (bf16)(u.y & 0xffff); d[216] = (bf16)(u.y >> 16);
            d[288] = (bf16)(u.z & 0xffff); d[360] = (bf16)(u.z >> 16); d[432] = (bf16)(u.w & 0xffff); d[504] = (bf16)(u.w >> 16); } }
    __syncthreads();
    {
        const int ib = w >> 1, half = w & 1, i = 16 * ib + r;
        bf16x8 scf[2];
#pragma unroll
        for (int s2 = 0; s2 < 2; ++s2) { f32x4 a0 = {0.f, 0.f, 0.f, 0.f}, a1 = {0.f, 0.f, 0.f, 0.f};
#pragma unroll
            for (int s = 0; s < 8; ++s) { const bf16x8 bq = *(const LAS bf16x8*)(Qr + i * 264 + 32 * s + 8 * q);
                const bf16x8 k0 = *(const LAS bf16x8*)(Kr + (32 * s2 + r) * 264 + 32 * s + 8 * q), k1 = *(const LAS bf16x8*)(Kr + (32 * s2 + 16 + r) * 264 + 32 * s + 8 * q);
                a0 = MFMA16(k0, bq, a0); a1 = MFMA16(k1, bq, a1); }
            f32x4 o0, o1;
#pragma unroll
            for (int d = 0; d < 4; ++d) { const int j0 = 32 * s2 + 4 * q + d, j1 = j0 + 16;
                o0[d] = (j0 <= i) ? a0[d] * __builtin_amdgcn_exp2f((float)(i - j0) * lg2) : 0.f; o1[d] = (j1 <= i) ? a1[d] * __builtin_amdgcn_exp2f((float)(i - j1) * lg2) : 0.f; }
            scf[s2] = pack8(o0, o1); }
#pragma unroll
        for (int x = 0; x < 8; ++x) { const int nb = 8 * half + x; f32x4 acc = {0.f, 0.f, 0.f, 0.f};
#pragma unroll
            for (int s2 = 0; s2 < 2; ++s2) { const LAS bf16* p = Vt + (16 * nb + r) * 72 + 32 * s2 + 4 * q; acc = MFMA16(scf[s2], ld2x8(p, p + 16), acc); }
            { v2u pw; pw.x = cvt2(acc[0], acc[1]); pw.y = cvt2(acc[2], acc[3]); *(v2u*)((bf16*)inner + ((nb * 4 + ib) * 64 + lane) * 4) = pw; } }
    }
#pragma unroll
    for (int x = 0; x < 4; ++x) { const int nb = 2 * w + (x >> 1), s2 = x & 1; const LAS bf16* p = Vt + (16 * nb + r) * 72 + 32 * s2 + 4 * q;
        *(bf16x8*)(vf + ((nb * 2 + s2) * 64 + lane) * 16) = ld2x8(p, p + 16); }
#pragma unroll 1
    for (int f = w; f < 32; f += 8) { const int mb = f >> 3, s = f & 7, i = 16 * mb + r; const LAS bf16* p = Qr + i * 264 + 32 * s + 4 * q;
        const v2u lo = *(const LAS v2u*)p, hi = *(const LAS v2u*)(p + 16); const float eg = __builtin_amdgcn_exp2f((float)(i + 1) * lg2);
        const f32x4 a = {bflo(lo.x) * eg, bfhi(lo.x) * eg, bflo(lo.y) * eg, bfhi(lo.y) * eg}, bb = {bflo(hi.x) * eg, bfhi(hi.x) * eg, bflo(hi.y) * eg, bfhi(hi.y) * eg};
        *(bf16x8*)(img + ((mb * 8 + s) * 64 + lane) * 16) = pack8(a, bb); }
#pragma unroll 1
    for (int f = w; f < 32; f += 8) { const int db = f >> 1, s2 = f & 1, dk = 16 * db + r; f32x4 a, bb;
#pragma unroll
        for (int e = 0; e < 4; ++e) { const int j0 = 32 * s2 + 4 * q + e, j1 = j0 + 16;
            a[e] = bf2f(Kr[j0 * 264 + dk]) * __builtin_amdgcn_exp2f((float)(63 - j0) * lg2); bb[e] = bf2f(Kr[j1 * 264 + dk]) * __builtin_amdgcn_exp2f((float)(63 - j1) * lg2); }
        *(bf16x8*)(img + 32768 + ((db * 2 + s2) * 64 + lane) * 16) = pack8(a, bb); }
    __syncthreads();
}
__device__ __forceinline__ void stage_image(LAS unsigned char* dst, const unsigned char* src, int npieces, int tid, int wave) {
    for (int k = 0; k < npieces; ++k)
        __builtin_amdgcn_global_load_lds((const unsigned*)(src + k * 8192 + tid * 16), (LAS unsigned*)(dst + k * 8192 + wave * 1024), 16, 0, 0);
}
__device__ __forceinline__ f32x4 gload16(const void* p) { return *(const f32x4*)p; }
__device__ __forceinline__ f32x4 gload8bf(const void* p) { const v2u w = *(const v2u*)p; return (f32x4){bflo(w.x), bfhi(w.x), bflo(w.y), bfhi(w.y)}; }
#define SCAN_WAIT4(n, a, b, cc, d) asm volatile("s_waitcnt vmcnt(" #n ")" : "+v"(a), "+v"(b), "+v"(cc), "+v"(d) :: "memory")
#define SCAN_WAIT2(n, a, b) asm volatile("s_waitcnt vmcnt(" #n ")" : "+v"(a), "+v"(b) :: "memory")
#define LDF(off) (*(const LAS bf16x8*)(buf + (off) + lane * 16))
#define SB() __builtin_amdgcn_sched_barrier(0)
__device__ __forceinline__ void scan_gdn(const Ctx& c, int u) {
    const int bh = u, b = bh >> 3, h = bh & 7, w = c.wave, lane = c.lane, q = lane >> 4, r = lane & 15;
    const bool active = true; const int dvb = w;
    const unsigned char* img0 = c.gimg + (size_t)bh * 64 * GIMG_BYTES;
    const bf16* u0 = (const bf16*)c.gu + (size_t)bh * 64 * 16384 + (dvb * 4) * 256 + lane * 4;
    bf16* obase = c.Ob + ((size_t)b * SEQ + 4 * q) * D + h * 128 + 16 * dvb + r;
    LAS float* cdl = (LAS float*)(c.lds + 2 * GIMG_BYTES);
    if (c.tid < 64) cdl[c.tid] = c.gcd[bh * 64 + c.tid];
    f32x4 S[8];
#pragma unroll
    for (int i = 0; i < 8; ++i) S[i] = (f32x4){0.f, 0.f, 0.f, 0.f};
    f32x4 U0, U1, U2, U3, N0, N1, N2, N3;
    stage_image(c.lds, img0, 7, c.tid, w);
    U0 = gload8bf(u0); U1 = gload8bf(u0 + 256); U2 = gload8bf(u0 + 512); U3 = gload8bf(u0 + 768);
    SCAN_WAIT4(0, U0, U1, U2, U3); N0 = U0; N1 = U1; N2 = U2; N3 = U3;
    __syncthreads();
#pragma unroll 1
    for (int n = 0; n < 64; ++n) {
        const LAS unsigned char* buf = c.lds + (n & 1) * GIMG_BYTES;
        if (n + 1 < 64) { stage_image(c.lds + ((n + 1) & 1) * GIMG_BYTES, img0 + (size_t)(n + 1) * GIMG_BYTES, 7, c.tid, w);
            const bf16* un = u0 + (size_t)(n + 1) * 16384; N0 = gload8bf(un); N1 = gload8bf(un + 256); N2 = gload8bf(un + 512); N3 = gload8bf(un + 768); }
        if (active) {
            const float cd = cdl[n];
            bf16x8 Sf[4];
#pragma unroll
            for (int s = 0; s < 4; ++s) Sf[s] = pack8(S[2 * s], S[2 * s + 1]);
            f32x4 D1[4]; D1[0] = U0; D1[1] = U1; D1[2] = U2; D1[3] = U3;
            f32x4 Oa[4];
            bf16x8 Df[2];
            bf16x8 fa[4], fb[4];
#pragma unroll
            for (int f = 0; f < 4; ++f) fa[f] = LDF(f * 1024);
            SB();
#pragma unroll
            for (int bt = 0; bt < 14; ++bt) {
                if (bt + 1 < 14) {
#pragma unroll
                    for (int f = 0; f < 4; ++f) { if (bt & 1) fa[f] = LDF(((bt + 1) * 4 + f) * 1024); else fb[f] = LDF(((bt + 1) * 4 + f) * 1024); }
                }
                SB();
                if (bt < 4) {
#pragma unroll
                    for (int f = 0; f < 4; ++f) D1[bt] = MFMA16((bt & 1) ? fb[f] : fa[f], Sf[f], D1[bt]);
                    if (bt == 3) { Df[0] = pack8(D1[0], D1[1]); Df[1] = pack8(D1[2], D1[3]); }
                } else if (bt < 8) {
                    f32x4 acc = {0.f, 0.f, 0.f, 0.f};
#pragma unroll
                    for (int f = 0; f < 4; ++f) acc = MFMA16((bt & 1) ? fb[f] : fa[f], Sf[f], acc);
                    Oa[bt - 4] = acc;
                } else if (bt < 10) {
#pragma unroll
                    for (int x = 0; x < 2; ++x) { const int mb = 2 * (bt - 8) + x; f32x4 acc = Oa[mb];
                        acc = MFMA16((bt & 1) ? fb[2 * x] : fa[2 * x], Df[0], acc); acc = MFMA16((bt & 1) ? fb[2 * x + 1] : fa[2 * x + 1], Df[1], acc);
                        bf16* op = obase + (size_t)(n * 64 + 16 * mb) * D;
                        op[0] = (bf16)f2bf(acc[0]); op[D] = (bf16)f2bf(acc[1]); op[2 * D] = (bf16)f2bf(acc[2]); op[3 * D] = (bf16)f2bf(acc[3]); }
                } else {
#pragma unroll
                    for (int x = 0; x < 2; ++x) { const int db = 2 * (bt - 10) + x; f32x4 acc = S[db] * cd;
                        acc = MFMA16((bt & 1) ? fb[2 * x] : fa[2 * x], Df[0], acc); acc = MFMA16((bt & 1) ? fb[2 * x + 1] : fa[2 * x + 1], Df[1], acc); S[db] = acc; }
                }
                SB();
            }
        }
        if (active) SCAN_WAIT4(16, N0, N1, N2, N3); else SCAN_WAIT4(0, N0, N1, N2, N3);
        U0 = N0; U1 = N1; U2 = N2; U3 = N3;
        LDS_WAIT(); __builtin_amdgcn_s_barrier(); asm volatile("" ::: "memory");
    }
}
__device__ __forceinline__ void scan_ret(const Ctx& c, int u) {
    const int qt = u & 1, bh = u >> 1, b = bh >> 2, h = bh & 3, w = c.wave, lane = c.lane, q = lane >> 4, r = lane & 15;
    const bool active = true; const int nb = 8 * qt + w;
    const unsigned char* img0 = c.rimg + (size_t)bh * 64 * RIMG_BYTES;
    const bf16* in0 = (const bf16*)c.rinner + (size_t)bh * 64 * 32768 + (nb * 4) * 256 + lane * 4;
    const unsigned char* vf0 = c.rvf + (size_t)bh * 64 * 32768 + ((nb * 2) * 64 + lane) * 16;
    bf16* obase = c.Ob + ((size_t)b * SEQ + 4 * q) * D + 1024 + h * 256 + 16 * nb + r;
    const float cd = exp2f(64.f * log2f(1.f - exp2f(-5.f - (float)h)));
    f32x4 S[16];
#pragma unroll
    for (int i = 0; i < 16; ++i) S[i] = (f32x4){0.f, 0.f, 0.f, 0.f};
    f32x4 I0, I1, I2, I3, N0, N1, N2, N3, V0, V1, W0, W1;
    stage_image(c.lds, img0, 8, c.tid, w);
    I0 = gload8bf(in0); I1 = gload8bf(in0 + 256); I2 = gload8bf(in0 + 512); I3 = gload8bf(in0 + 768); V0 = gload16(vf0); V1 = gload16(vf0 + 1024);
    SCAN_WAIT4(0, I0, I1, I2, I3); SCAN_WAIT2(0, V0, V1); N0 = I0; N1 = I1; N2 = I2; N3 = I3; W0 = V0; W1 = V1;
    __syncthreads();
#pragma unroll 1
    for (int n = 0; n < 64; ++n) {
        const LAS unsigned char* buf = c.lds + (n & 1) * RIMG_BYTES;
        if (n + 1 < 64) { stage_image(c.lds + ((n + 1) & 1) * RIMG_BYTES, img0 + (size_t)(n + 1) * RIMG_BYTES, 8, c.tid, w);
            const bf16* inn = in0 + (size_t)(n + 1) * 32768; const unsigned char* vn = vf0 + (size_t)(n + 1) * 32768;
            N0 = gload8bf(inn); N1 = gload8bf(inn + 256); N2 = gload8bf(inn + 512); N3 = gload8bf(inn + 768); W0 = gload16(vn); W1 = gload16(vn + 1024); }
        if (active) {
            bf16x8 Sf[8];
#pragma unroll
            for (int s = 0; s < 8; ++s) Sf[s] = pack8(S[2 * s], S[2 * s + 1]);
            const bf16x8 Vf0 = __builtin_bit_cast(bf16x8, V0), Vf1 = __builtin_bit_cast(bf16x8, V1);
            f32x4 Oa[4]; Oa[0] = I0; Oa[1] = I1; Oa[2] = I2; Oa[3] = I3;
            bf16x8 fa[4], fb[4];
#pragma unroll
            for (int f = 0; f < 4; ++f) fa[f] = LDF(f * 1024);
            SB();
#pragma unroll
            for (int bt = 0; bt < 16; ++bt) {
                if (bt + 1 < 16) {
#pragma unroll
                    for (int f = 0; f < 4; ++f) { if (bt & 1) fa[f] = LDF(((bt + 1) * 4 + f) * 1024); else fb[f] = LDF(((bt + 1) * 4 + f) * 1024); }
                }
                SB();
                if (bt < 8) { const int mb = bt >> 1; f32x4 acc = Oa[mb];
#pragma unroll
                    for (int f = 0; f < 4; ++f) acc = MFMA16((bt & 1) ? fb[f] : fa[f], Sf[4 * (bt & 1) + f], acc);
                    Oa[mb] = acc;
                    if (bt & 1) { bf16* op = obase + (size_t)(n * 64 + 16 * mb) * D; op[0] = (bf16)f2bf(acc[0]); op[D] = (bf16)f2bf(acc[1]); op[2 * D] = (bf16)f2bf(acc[2]); op[3 * D] = (bf16)f2bf(acc[3]); }
                } else {
#pragma unroll
                    for (int x = 0; x < 2; ++x) { const int db = 2 * (bt - 8) + x; f32x4 acc = S[db] * cd;
                        acc = MFMA16((bt & 1) ? fb[2 * x] : fa[2 * x], Vf0, acc); acc = MFMA16((bt & 1) ? fb[2 * x + 1] : fa[2 * x + 1], Vf1, acc); S[db] = acc; }
                }
                SB();
            }
        }
        if (active) { SCAN_WAIT4(16, N0, N1, N2, N3); SCAN_WAIT2(16, W0, W1); } else { SCAN_WAIT4(0, N0, N1, N2, N3); SCAN_WAIT2(0, W0, W1); }
        I0 = N0; I1 = N1; I2 = N2; I3 = N3; V0 = W0; V1 = W1;
        LDS_WAIT(); __builtin_amdgcn_s_barrier(); asm volatile("" ::: "memory");
    }
}
#undef LDF
#undef SB
__device__ __forceinline__ void ph_mixer_prep(const Ctx& c) {
    prep_gdn_all(c);
    for (int u = c.bid; u < 1024; u += c.G) prep_ret(c, u);
}
__device__ __forceinline__ void ph_mixer_scan(const Ctx& c) {
    for (int u = c.bid; u < SCAN_UNITS; u += c.G) { if (u < 32) scan_gdn(c, u); else { const int v = u - 32, xcd = v & 7, grp = v >> 3; scan_ret(c, (xcd + 8 * (grp >> 1)) * 2 + (grp & 1)); } __syncthreads(); }
    if (c.G > SCAN_UNITS) {
        unsigned* qw = (unsigned*)c.ctl + CW_CONVQ;
        LAS unsigned* slot = (LAS unsigned*)(c.lds + 8 * 8704);
        LAS float* scr = (LAS float*)(c.lds + c.wave * 8704);
        for (;;) {
            __syncthreads();
            if (c.tid == 0) *slot = __hip_atomic_fetch_add(qw, 16u, __ATOMIC_RELAXED, __HIP_MEMORY_SCOPE_AGENT);
            __syncthreads();
            const unsigned base = *slot;
            if (base >= (unsigned)(IT_ALL - IT_SMALL)) break;
            const float *Wa, *Wb; int la, lb, sa, sb2, ka, kb2; unsigned char *Ta, *Tb; size_t da, db;
            f8item_addr(c, (int)base + c.wave, Wa, la, sa, ka, Ta, da); f8item_addr(c, (int)base + 8 + c.wave, Wb, lb, sb2, kb2, Tb, db);
            f32x4 ra[8], rb[8];
            f8item_load(Wa, la, sa, ka, c.lane, ra); f8item_load(Wb, lb, sb2, kb2, c.lane, rb);
            f8item_emit(ra, Ta, da, ka, scr, c.lane); f8item_emit(rb, Tb, db, kb2, scr, c.lane);
        }
    }
}

__device__ __forceinline__ void ph_gemm_inproj(const Ctx& c) {
    pg8::Sched S; S.init(c.H, c.win_t, nullptr, T / 256, NPROJ, c.G, c.vcu, (size_t)D * 2);
    pg8::gemm_phase(c.lds, S, pg8::EpiProj{c.PROJ, NPROJ});
}
__device__ __forceinline__ void ph_gemm_outproj(const Ctx& c) {
    pg8::Sched S; S.init(c.H, c.wout_t, nullptr, T / 256, D, c.G, c.vcu, (size_t)D * 2);
    pg8::gemm_phase(c.lds, S, pg8::EpiResid{c.x, c.mod, c.X1});
}
__device__ __forceinline__ void ph_gemm_up(const Ctx& c) {
    const int nmt = __builtin_amdgcn_readfirstlane(c.meta[0]);
    pg8::Sched S; S.init(c.XS8, c.w1_q, c.tile_e, nmt, 4096, c.G, c.vcu, (size_t)D);
    pg8::gemm_phase_f8(c.lds, S, pg8::EpiUpF8{c.ACT8, c.b1, c.tile_e});
}
__device__ __forceinline__ void ph_gemm_down(const Ctx& c) {
    const int nmt = __builtin_amdgcn_readfirstlane(c.meta[0]);
    pg8::Sched S; S.init(c.ACT8, c.w2_q, c.tile_e, nmt, D, c.G, c.vcu, (size_t)D);
    pg8::gemm_phase_f8(c.lds, S, pg8::EpiDown{c.Y, c.b2, c.tile_e, c.row_gate});
}

struct Args { const void* in[22]; float* out; unsigned char* ws; int ph_lo, ph_hi, li, pad; };
__global__ void __launch_bounds__(NTHREADS, 2) fwd_kernel(Args a) {
    extern __shared__ __attribute__((aligned(16))) unsigned char lds_raw[];
    Ctx c;
    c.lds = (LAS unsigned char*)lds_raw;
    c.tid = threadIdx.x; c.lane = c.tid & 63; c.wave = __builtin_amdgcn_readfirstlane(c.tid >> 6); c.G = gridDim.x; c.bid = blockIdx.x;
    c.x = (const float*)a.in[0]; c.c_in = (const float*)a.in[1]; c.positions = (const int*)a.in[2];
    c.ada_w = (const float*)a.in[3]; c.ada_b = (const float*)a.in[4]; c.norm1_g = (const float*)a.in[5]; c.w_in = (const float*)a.in[6]; c.conv_w = (const float*)a.in[7];
    c.a_log = (const float*)a.in[8]; c.dt_bias = (const float*)a.in[9]; c.gdn_norm_g = (const float*)a.in[10]; c.ret_norm_g = (const float*)a.in[11]; c.ret_norm_b = (const float*)a.in[12];
    c.w_out = (const float*)a.in[13]; c.norm2_g = (const float*)a.in[14]; c.w_router = (const float*)a.in[15]; c.b_router = (const float*)a.in[16];
    c.w1 = (const float*)a.in[17]; c.b1 = (const float*)a.in[18]; c.w2 = (const float*)a.in[19]; c.b2 = (const float*)a.in[20]; c.final_g = (const float*)a.in[21];
    c.out = a.out;
    unsigned char* ws = a.ws;
    c.ctl = (unsigned*)(ws + WS_CTL); c.mod = (float*)(ws + WS_MOD); c.tok_e = (int*)(ws + WS_TOKE); c.tok_g = (float*)(ws + WS_TOKG); c.tok_pos = (int*)(ws + WS_TOKP); c.blk_cnt = (int*)(ws + WS_BCNT);
    c.tile_e = (int*)(ws + WS_TILEE); c.meta = (int*)(ws + WS_META); c.row_gate = (float*)(ws + WS_RGATE); c.row_tok = (int*)(ws + WS_RTOK);
    c.ba = (float*)(ws + WS_BA); c.wba_t = (float*)(ws + WS_WBAT); c.wr_t = (float*)(ws + WS_WRT);
    c.win_t = (bf16*)(ws + WS_WIN); c.wout_t = (bf16*)(ws + WS_WOUT); c.w1_q = ws + WS_W1; c.w2_q = ws + WS_W2;
    c.H = (bf16*)(ws + WS_H); c.PROJ = (bf16*)(ws + WS_PROJ); c.Y = (bf16*)(ws + WS_Y); c.H8 = ws + WS_H + 32 * MiB; c.XS8 = ws + WS_XS; c.ACT8 = ws + WS_ACT;
    c.O = (float*)(ws + WS_O); c.Ob = (bf16*)(ws + WS_O); c.X1 = (bf16*)(ws + WS_X1);
    c.gimg = ws + WS_GIMG; c.rimg = ws + WS_RIMG; c.rvf = ws + WS_RVF; c.gu = (float*)(ws + WS_GU); c.rinner = (float*)(ws + WS_RINNER); c.gcd = (float*)(ws + WS_GCD); c.rot = (f32x2*)(ws + WS_ROT);

    volatile LAS unsigned* misc = (volatile LAS unsigned*)(c.lds + MISC_OFF);
    if (c.tid < 16) misc[c.tid] = 0u;
    __syncthreads();
    XcdBarrier bar; bar.bar = (unsigned*)(ws + WS_CTL) + CW_BAR + a.li * XCD_BAR_WORDS; bar.x = 0; bar.st = misc;
    if (N_LAUNCH_MODE == 1) bar = xcd_barrier_post((unsigned*)(ws + WS_CTL) + CW_BAR + a.li * XCD_BAR_WORDS, misc);
    if (c.tid == 0) { const unsigned xcc = xb_xcc_id(); misc[8] = xcc; misc[9] = __hip_atomic_fetch_add(c.ctl + 1024 + 64 * xcc, 1u, __ATOMIC_RELAXED, __HIP_MEMORY_SCOPE_AGENT); }
    c.vcu = c.bid;
    const int lo = a.ph_lo, hi = a.ph_hi;
#ifdef ONLY_PHASE
#define IN(k) ((k) == ONLY_PHASE && lo <= (k) && (k) < hi)
#else
#define IN(k) (lo <= (k) && (k) < hi)
#endif
#define SEAM(k) do { if (N_LAUNCH_MODE == 1 && IN(k) && IN((k) + 1)) xcd_barrier(bar); else __syncthreads(); } while (0)
    if (IN(0)) { ph_prologue(c); } SEAM(0);
    if (N_LAUNCH_MODE == 1 && IN(0) && IN(1)) {
        if (c.tid == 0) { bool ok = (c.G % 8) == 0;
            for (int x = 0; x < 8; ++x) { const unsigned n = __hip_atomic_load(c.ctl + 1024 + 64 * x, __ATOMIC_RELAXED, __HIP_MEMORY_SCOPE_AGENT); ok = ok && (n == (unsigned)(c.G / 8)); }
            misc[10] = ok ? misc[8] + 8u * misc[9] : (unsigned)c.bid; }
        __syncthreads();
        c.vcu = __builtin_amdgcn_readfirstlane((int)misc[10]);
    }
    if (IN(1)) { ph_norm1(c); } SEAM(1);
    if (IN(2)) { ph_gemm_inproj(c); } SEAM(2);
#if NAIVE_MIXER
    if (IN(3)) { } SEAM(3);
    if (IN(4)) { ph_mixer_naive(c); } SEAM(4);
#else
    if (IN(3)) { ph_mixer_prep(c); } SEAM(3);
    if (IN(4)) { ph_mixer_scan(c); } SEAM(4);
#endif
    if (IN(5)) { ph_gatenorm(c); } SEAM(5);
    if (IN(6)) { ph_gemm_outproj(c); } SEAM(6);
    if (IN(7)) { ph_router(c); } SEAM(7);
    if (IN(8)) { ph_route2(c); } SEAM(8);
    if (IN(9)) { ph_gemm_up(c); } SEAM(9);
    if (IN(10)) { ph_gemm_down(c); } SEAM(10);
    if (IN(11)) { ph_final(c); }
#undef IN
#undef SEAM
}

extern "C" void kernel_launch(void* const* d_in, const int* in_sizes, int n_in, void* d_out, int out_size, void* d_ws, size_t ws_size, hipStream_t stream) {
    static int grid = 0;
    if (grid == 0) {
        if (n_in != 22 || out_size != T * D || ws_size < WS_END) { fprintf(stderr, "kernel_launch: unexpected shapes (n_in %d out %d ws %zu)\n", n_in, out_size, ws_size); grid = -1; return; }
        int dev = 0, cus = 0, per_cu = 0;
        if (hipGetDevice(&dev) != hipSuccess || hipDeviceGetAttribute(&cus, hipDeviceAttributeMultiprocessorCount, dev) != hipSuccess) { grid = -1; return; }
        if (hipFuncSetAttribute((const void*)fwd_kernel, hipFuncAttributeMaxDynamicSharedMemorySize, LDS_BYTES) != hipSuccess) { fprintf(stderr, "kernel_launch: hipFuncSetAttribute failed\n"); grid = -1; return; }
        if (hipOccupancyMaxActiveBlocksPerMultiprocessor(&per_cu, (const void*)fwd_kernel, NTHREADS, LDS_BYTES) != hipSuccess || per_cu < 1) fprintf(stderr, "kernel_launch: occupancy query says %d\n", per_cu);
        (void)hipGetLastError();
        grid = cus;
    }
    if (grid < 0) return;
    (void)hipMemsetAsync((char*)d_ws + WS_CTL, 0, CTL_ZERO_BYTES, stream);
    Args a{};
    for (int i = 0; i < 22; ++i) a.in[i] = d_in[i];
    a.out = (float*)d_out; a.ws = (unsigned char*)d_ws;
#ifdef PROBE_DUP
    a.ph_lo = 0; a.ph_hi = PROBE_DUP + 1; a.li = 0; hipLaunchKernelGGL(fwd_kernel, dim3(grid), dim3(NTHREADS), LDS_BYTES, stream, a);
    a.ph_lo = PROBE_DUP; a.ph_hi = NPHASES; a.li = 1; hipLaunchKernelGGL(fwd_kernel, dim3(grid), dim3(NTHREADS), LDS_BYTES, stream, a);
    return;
#endif
    if (N_LAUNCH_MODE == 1) { a.ph_lo = 0; a.ph_hi = NPHASES; hipLaunchKernelGGL(fwd_kernel, dim3(grid), dim3(NTHREADS), LDS_BYTES, stream, a); }
    else for (int p = 0; p < NPHASES; ++p) { if (p == 3) continue; a.ph_lo = p; a.ph_hi = p + 1; hipLaunchKernelGGL(fwd_kernel, dim3(grid), dim3(NTHREADS), LDS_BYTES, stream, a); }
}
```
